# Optimizing an MI355X kernel written in HIP

```python
import math
import jax, jax.numpy as jnp
from jax import lax
import numpy as np

D_MODEL = 1024
BATCH = 4
SEQ = 8192
DEPTH = 4

CHUNK = 64
Q_BLOCK = 128
N_A_LAYERS = DEPTH // 2
N_B_LAYERS = DEPTH - N_A_LAYERS
A_HEADS = 8
A_NOPE = 128
A_ROPE = 64
A_VDIM = 128
A_QK = A_NOPE + A_ROPE
A_Q_LORA = 384
A_KV_LORA = 256
A_WIDTH = A_HEADS * A_VDIM
A_IN = A_Q_LORA + A_KV_LORA + A_ROPE + A_WIDTH
ROPE_THETA = 10000.0
B_Q_HEADS = 16
B_KV_HEADS = 2
B_GROUP = B_Q_HEADS // B_KV_HEADS
B_HEAD_DIM = 64
B_WIDTH = B_Q_HEADS * B_HEAD_DIM
B_KV_WIDTH = B_KV_HEADS * B_HEAD_DIM
WINDOW = 128
WIN_CHUNKS = WINDOW // CHUNK
NUM_BUCKETS = 32
MAX_DISTANCE = 128
DEEPNORM_ALPHA = (2 * DEPTH) ** 0.25
DEEPNORM_BETA = (8 * DEPTH) ** -0.25
NORM_EPS = 1e-5
MASK_VALUE = -1e30

kernel_name = "yoco_mla_swa_sink_deepnorm"


def _rms_norm(x, g):
    xf = x.astype(jnp.float32)
    y = xf * lax.rsqrt(jnp.mean(xf * xf, axis=-1, keepdims=True) + NORM_EPS)
    return (y * g.astype(jnp.float32)).astype(x.dtype)


def _layer_norm(x, g, b):
    xf = x.astype(jnp.float32)
    mu = jnp.mean(xf, axis=-1, keepdims=True)
    var = jnp.mean(jnp.square(xf - mu), axis=-1, keepdims=True)
    y = (xf - mu) * lax.rsqrt(var + NORM_EPS) * g.astype(jnp.float32) + b.astype(jnp.float32)
    return y.astype(x.dtype)


def _rope(t, seq_len):
    half = A_ROPE // 2
    inv = ROPE_THETA ** (-jnp.arange(half, dtype=jnp.float32) / half)
    ang = jnp.arange(seq_len, dtype=jnp.float32)[:, None] * inv[None, :]
    cos, sin = jnp.cos(ang)[:, None, :], jnp.sin(ang)[:, None, :]
    tf = t.astype(jnp.float32)
    t1, t2 = tf[..., :half], tf[..., half:]
    return jnp.concatenate([t1 * cos - t2 * sin, t2 * cos + t1 * sin], axis=-1).astype(t.dtype)


def _mla_attention(q_nope, q_rope, k_nope, k_rope, v):
    B, S, H, _ = q_nope.shape
    nb = S // Q_BLOCK
    scale = A_QK ** -0.5
    key_chunk = jnp.arange(S) // CHUNK

    def blockify(t):
        return jnp.moveaxis(t.reshape((B, nb, Q_BLOCK) + t.shape[2:]), 1, 0)

    def one_block(args):
        qn, qr, blk = args
        s = (jnp.einsum('bqhd,bkhd->bhqk', qn, k_nope, preferred_element_type=jnp.float32)
             + jnp.einsum('bqhd,bkd->bhqk', qr, k_rope, preferred_element_type=jnp.float32)) * scale
        q_chunk = (blk * Q_BLOCK + jnp.arange(Q_BLOCK)) // CHUNK
        visible = key_chunk[None, :] <= q_chunk[:, None]
        p = jax.nn.softmax(jnp.where(visible, s, MASK_VALUE), axis=-1)
        return jnp.einsum('bhqk,bkhd->bqhd', p.astype(v.dtype), v)

    o = lax.map(one_block, (blockify(q_nope), blockify(q_rope), jnp.arange(nb)))
    return jnp.moveaxis(o, 0, 1).reshape(B, S, H, v.shape[-1])


def _mla_mixer(x, w_in, q_norm, kv_norm, w_uq, w_ukv, w_o):
    B, S, _ = x.shape
    h = x @ w_in
    c_q, c_kv, k_rope, gate = jnp.split(
        h, [A_Q_LORA, A_Q_LORA + A_KV_LORA, A_Q_LORA + A_KV_LORA + A_ROPE], axis=-1)
    q = (_rms_norm(c_q, q_norm) @ w_uq).reshape(B, S, A_HEADS, A_QK)
    kv = (_rms_norm(c_kv, kv_norm) @ w_ukv).reshape(B, S, A_HEADS, A_NOPE + A_VDIM)
    q_nope, q_rope = q[..., :A_NOPE], _rope(q[..., A_NOPE:], S)
    k_rope = _rope(k_rope[:, :, None, :], S)[:, :, 0, :]
    k_nope, v = kv[..., :A_NOPE], kv[..., A_NOPE:]
    o = _mla_attention(q_nope, q_rope, k_nope, k_rope, v).reshape(B, S, A_WIDTH)
    return (o * jax.nn.silu(gate)) @ w_o


def _t5_bucket(rel):
    half = NUM_BUCKETS // 2
    ret = jnp.where(rel > 0, half, 0)
    n = jnp.abs(rel)
    max_exact = half // 2
    large = max_exact + (jnp.log(jnp.maximum(n, 1).astype(jnp.float32) / max_exact)
                         / math.log(MAX_DISTANCE / max_exact) * (half - max_exact)).astype(jnp.int32)
    large = jnp.minimum(large, half - 1)
    return ret + jnp.where(n < max_exact, n, large)


def _band_structure(seq_len):
    nb = seq_len // Q_BLOCK
    r = jnp.arange(Q_BLOCK)
    j = jnp.arange(2 * Q_BLOCK)
    rel = j[None, :] - Q_BLOCK - r[:, None]
    d = (r // CHUNK)[:, None] - ((j - Q_BLOCK) // CHUNK)[None, :]
    rel_ok = (d >= 0) & (d <= WIN_CHUNKS)
    kpos = jnp.arange(nb)[:, None] * Q_BLOCK - Q_BLOCK + j[None, :]
    mask = rel_ok[None, :, :] & (kpos >= 0)[:, None, :]
    return rel, mask


def _band(t):
    B, S = t.shape[:2]
    nb = S // Q_BLOCK
    tp = jnp.pad(t, ((0, 0), (Q_BLOCK, 0), (0, 0), (0, 0))).reshape((B, nb + 1, Q_BLOCK) + t.shape[2:])
    return jnp.concatenate([tp[:, :-1], tp[:, 1:]], axis=2)


def _swa_sink_mixer(x, k_band, v_band, band_bias, band_mask, w_in, sinks, w_o):
    B, S, _ = x.shape
    nb = S // Q_BLOCK
    h = x @ w_in
    q, gate = jnp.split(h, [B_WIDTH], axis=-1)
    q = q.reshape(B, nb, Q_BLOCK, B_KV_HEADS, B_GROUP, B_HEAD_DIM)
    s = jnp.einsum('bnqhgd,bnkhd->bnhgqk', q, k_band, preferred_element_type=jnp.float32)
    s = s * (B_HEAD_DIM ** -0.5) + band_bias
    s = jnp.where(band_mask[None, :, None, None, :, :], s, MASK_VALUE)
    sink = sinks.astype(jnp.float32).reshape(1, 1, B_KV_HEADS, B_GROUP, 1, 1)
    m = jnp.maximum(jnp.max(s, axis=-1, keepdims=True), sink)
    e = jnp.exp(s - m)
    p = e / (jnp.sum(e, axis=-1, keepdims=True) + jnp.exp(sink - m))
    o = jnp.einsum('bnhgqk,bnkhd->bnqhgd', p.astype(v_band.dtype), v_band).reshape(B, S, B_WIDTH)
    return (o * jax.nn.silu(gate)) @ w_o


def setup_inputs(seed: int = 0) -> dict:
    key = jax.random.key(seed)
    ks = jax.random.split(key, 14)
    f32 = jnp.float32
    nrm = lambda k, shape, scale: jax.random.normal(k, shape, f32) * scale
    return {
        "x": nrm(ks[0], (BATCH, SEQ, D_MODEL), 1.0),
        "w_in_a": nrm(ks[1], (N_A_LAYERS, D_MODEL, A_IN), D_MODEL ** -0.5),
        "q_norm_a": 1.0 + nrm(ks[2], (N_A_LAYERS, A_Q_LORA), 0.02),
        "kv_norm_a": 1.0 + nrm(ks[3], (N_A_LAYERS, A_KV_LORA), 0.02),
        "w_uq_a": nrm(ks[4], (N_A_LAYERS, A_Q_LORA, A_HEADS * A_QK), A_Q_LORA ** -0.5),
        "w_ukv_a": nrm(ks[5], (N_A_LAYERS, A_KV_LORA, A_HEADS * (A_NOPE + A_VDIM)), A_KV_LORA ** -0.5),
        "w_o_a": nrm(ks[6], (N_A_LAYERS, A_WIDTH, D_MODEL), A_WIDTH ** -0.5 * DEEPNORM_BETA),
        "w_kv_shared": nrm(ks[7], (D_MODEL, 2 * B_KV_WIDTH), D_MODEL ** -0.5),
        "w_in_b": nrm(ks[8], (N_B_LAYERS, D_MODEL, 2 * B_WIDTH), D_MODEL ** -0.5),
        "sinks_b": nrm(ks[9], (N_B_LAYERS, B_Q_HEADS), 0.5),
        "w_o_b": nrm(ks[10], (N_B_LAYERS, B_WIDTH, D_MODEL), B_WIDTH ** -0.5 * DEEPNORM_BETA),
        "rel_bias_table": nrm(ks[11], (NUM_BUCKETS, B_Q_HEADS), 0.2),
        "ln_gain": 1.0 + nrm(ks[12], (DEPTH, D_MODEL), 0.02),
        "ln_bias": nrm(ks[13], (DEPTH, D_MODEL), 0.02),
    }


def reference(x, w_in_a, q_norm_a, kv_norm_a, w_uq_a, w_ukv_a, w_o_a, w_kv_shared,
              w_in_b, sinks_b, w_o_b, rel_bias_table, ln_gain, ln_bias):
    S = x.shape[1]
    rel, band_mask = _band_structure(S)
    band_bias = jnp.transpose(rel_bias_table[_t5_bucket(rel)], (2, 0, 1)).astype(jnp.float32)
    band_bias = band_bias.reshape(B_KV_HEADS, B_GROUP, Q_BLOCK, 2 * Q_BLOCK)
    k_band = v_band = None
    for layer in range(DEPTH):
        if layer < N_A_LAYERS:
            i = layer
            y = _mla_mixer(x, w_in_a[i], q_norm_a[i], kv_norm_a[i], w_uq_a[i], w_ukv_a[i], w_o_a[i])
        else:
            j = layer - N_A_LAYERS
            y = _swa_sink_mixer(x, k_band, v_band, band_bias, band_mask, w_in_b[j], sinks_b[j], w_o_b[j])
        x = _layer_norm(DEEPNORM_ALPHA * x + y, ln_gain[layer], ln_bias[layer])
        if layer == N_A_LAYERS - 1:
            B = x.shape[0]
            k, v = jnp.split(x @ w_kv_shared, 2, axis=-1)
            k_band = _band(k.reshape(B, S, B_KV_HEADS, B_HEAD_DIM))
            v_band = _band(v.reshape(B, S, B_KV_HEADS, B_HEAD_DIM))
    return x
```

```cpp
#ifndef PROBE
#define PROBE 0
#endif
#include <hip/hip_runtime.h>
#include <hip/hip_cooperative_groups.h>
#include <cstdio>
#include <cstring>
namespace cg = cooperative_groups;

typedef unsigned short bf16_t;
typedef __attribute__((ext_vector_type(8))) short bf16x8;
typedef __attribute__((ext_vector_type(16))) float f32x16;
typedef __attribute__((ext_vector_type(4))) float f32x4;
typedef __attribute__((ext_vector_type(4))) unsigned u32x4;
typedef __attribute__((ext_vector_type(2))) unsigned u32x2;

#define DEV __device__ __forceinline__
#define PHASE_FN __device__ __forceinline__

constexpr int T_TOK = 32768;
constexpr int SEQ = 8192;
constexpr int DM = 1024;
constexpr float LOG2E = 1.4426950408889634f;
constexpr float QSCALE_A = 0.07216878364870322f * LOG2E;
constexpr float QSCALE_B = 0.125f * LOG2E;
constexpr float DN_ALPHA = 1.681792830507429f;
constexpr float EPS = 1e-5f;
constexpr int NTHR = 512;
constexpr int NWAVE = 8;

constexpr size_t SZ_WT_IN_A = (size_t)1792 * 1024 * 2;
constexpr size_t SZ_WT_UQ = (size_t)1536 * 384 * 2;
constexpr size_t SZ_WT_UKV = (size_t)2048 * 256 * 2;
constexpr size_t SZ_WT_O = (size_t)1024 * 1024 * 2;
constexpr size_t SZ_WT_IN_B0 = (size_t)2304 * 1024 * 2;
constexpr size_t SZ_WT_IN_B1 = (size_t)2048 * 1024 * 2;
constexpr size_t OFF_WT_IN_A = 0;
constexpr size_t OFF_WT_UQ = OFF_WT_IN_A + 2 * SZ_WT_IN_A;
constexpr size_t OFF_WT_UKV = OFF_WT_UQ + 2 * SZ_WT_UQ;
constexpr size_t OFF_WT_O_A = OFF_WT_UKV + 2 * SZ_WT_UKV;
constexpr size_t OFF_WT_IN_B0 = OFF_WT_O_A + 2 * SZ_WT_O;
constexpr size_t OFF_WT_IN_B1 = OFF_WT_IN_B0 + SZ_WT_IN_B0;
constexpr size_t OFF_WT_O_B = OFF_WT_IN_B1 + SZ_WT_IN_B1;
constexpr size_t OFF_COS = OFF_WT_O_B + 2 * SZ_WT_O;
constexpr size_t OFF_SIN = OFF_COS + (size_t)SEQ * 32 * 4;
constexpr size_t OFF_BIAS = OFF_SIN + (size_t)SEQ * 32 * 4;
constexpr size_t OFF_CNT = OFF_BIAS + 16 * 256 * 4;
constexpr size_t OFF_BAR = OFF_CNT + 4096;
constexpr size_t OFF_PART = OFF_BAR + 16384;
constexpr size_t OFF_CSBW = OFF_PART + 2 * 16 * 6144 * 4;
constexpr size_t OFF_PSUM = OFF_CSBW + 2 * 6144 * 4;
constexpr size_t OFF_STATS = OFF_PSUM + (size_t)T_TOK * 8 * 4;
constexpr size_t OFF_XB = OFF_STATS + (size_t)3 * T_TOK * 2 * 4;
constexpr size_t OFF_CQKV = OFF_XB + (size_t)T_TOK * 1024 * 2;
constexpr size_t OFF_KROPE = OFF_CQKV + (size_t)T_TOK * 640 * 2;
constexpr size_t OFF_SGATE = OFF_KROPE + (size_t)T_TOK * 64 * 2;
constexpr size_t OFF_Q = OFF_SGATE + (size_t)T_TOK * 1024 * 2;
constexpr size_t OFF_KN = OFF_Q + (size_t)T_TOK * 1536 * 2;
constexpr size_t OFF_VT = OFF_KN + (size_t)T_TOK * 1024 * 2;
constexpr size_t OFF_OG = OFF_VT + (size_t)T_TOK * 1024 * 2;
constexpr size_t WS_NEEDED = OFF_OG + (size_t)T_TOK * 1024 * 2;

struct Params {
  const float* in[14];
  float* out;
  char* ws;
  int phase_lo, phase_hi;
};

DEV unsigned cvtpk(float lo, float hi) {
  unsigned r;
  asm("v_cvt_pk_bf16_f32 %0, %1, %2" : "=v"(r) : "v"(lo), "v"(hi));
  return r;
}
DEV bf16_t f2bf(float v) { return (bf16_t)(cvtpk(v, v) & 0xffffu); }
DEV float bf2f(bf16_t v) { return __uint_as_float(((unsigned)v) << 16); }
DEV float swapmax(float v) {
  auto rr = __builtin_amdgcn_permlane32_swap(__float_as_uint(v), __float_as_uint(v), false, false);
  return fmaxf(__uint_as_float(rr[0]), __uint_as_float(rr[1]));
}
DEV float swapsum(float v) {
  auto rr = __builtin_amdgcn_permlane32_swap(__float_as_uint(v), __float_as_uint(v), false, false);
  return __uint_as_float(rr[0]) + __uint_as_float(rr[1]);
}
DEV int otid() { int t = threadIdx.x; asm volatile("" : "+v"(t)); return t; }
DEV float silu(float v) { return v * __builtin_amdgcn_rcpf(1.f + __builtin_amdgcn_exp2f(-1.4426950408889634f * v)); }
DEV float wave_sum(float v) {
#pragma unroll
  for (int o = 32; o >= 1; o >>= 1) v += __shfl_xor(v, o);
  return v;
}

#define LAS __attribute__((address_space(3)))
constexpr int HTB = 128 * 64 * 2;
constexpr int GEMM_LDS = 8 * HTB;
constexpr int SMEM_BYTES = 3 * (26624 + 18432) + 1024;
#define SA_(b, h) (((b) * 2 + (h)) * HTB)
#define SB_(b, h) ((4 + (b) * 2 + (h)) * HTB)

DEV int lds_byte(int r, int c) {
  int st = (r >> 4) * 2 + (c >> 5), rr = r & 15, cc = c & 31, ob = rr * 64 + cc * 2;
  return st * 1024 + (ob ^ (((ob >> 9) & 1) << 5));
}
DEV void stage_rc(int b, int& R, int& C) {
  int st = b >> 10, sb = b & 1023, swz = sb ^ (((sb >> 9) & 1) << 5);
  R = (st >> 1) * 16 + (swz >> 6);
  C = (st & 1) * 32 + ((swz & 63) >> 1);
}

template <bool SWAP>
DEV void mma_blk(f32x4 (&acc)[4][2], const bf16x8 (&At)[4][2], const bf16x8 (&Bf)[2][2]) {
  __builtin_amdgcn_s_setprio(1);
#pragma unroll
  for (int m = 0; m < 4; ++m)
#pragma unroll
    for (int n = 0; n < 2; ++n)
#pragma unroll
      for (int k = 0; k < 2; ++k) {
        if (SWAP) acc[m][n] = __builtin_amdgcn_mfma_f32_16x16x32_bf16(Bf[n][k], At[m][k], acc[m][n], 0, 0, 0);
        else acc[m][n] = __builtin_amdgcn_mfma_f32_16x16x32_bf16(At[m][k], Bf[n][k], acc[m][n], 0, 0, 0);
      }
  __builtin_amdgcn_s_setprio(0);
}

template <bool VT1>
DEV void gemm256(const bf16_t* __restrict__ A, int lda, const bf16_t* __restrict__ Bt, int ldb, int K, int brow, int bcol,
                 LAS unsigned char* lds, f32x4 (&acc)[2][2][4][2]) {
  const int tid = otid();
  const int wid = __builtin_amdgcn_readfirstlane(tid >> 6), lane = tid & 63, wr = wid >> 2, wc = wid & 3, fr = lane & 15, fq = lane >> 4;
  const int nt = K >> 6;
  unsigned voffA[2], voffB[2];
#pragma unroll
  for (int i = 0; i < 2; ++i) {
    int R, C;
    stage_rc(tid * 16 + i * 8192, R, C);
    voffA[i] = (unsigned)(R * lda + C) * 2u;
    voffB[i] = (unsigned)(R * ldb + C) * 2u;
  }
  const size_t hA = (size_t)128 * lda * 2, hB = (size_t)128 * ldb * 2;
  const unsigned ldsw = (unsigned)wid * 1024u;
  const int aoff = lds_byte(wr * 64 + fr, fq * 8), boff = lds_byte(wc * 32 + fr, fq * 8);
  const char* cA = (const char*)A + (size_t)brow * lda * 2;
  const char* cB = (const char*)Bt + (size_t)bcol * ldb * 2;
#pragma unroll
  for (int a = 0; a < 2; ++a)
#pragma unroll
    for (int b = 0; b < 2; ++b)
#pragma unroll
      for (int m = 0; m < 4; ++m)
#pragma unroll
        for (int n = 0; n < 2; ++n) acc[a][b][m][n] = (f32x4){0.f, 0.f, 0.f, 0.f};
  bf16x8 At[4][2], B0[2][2], B1[2][2];
#define STAGE(bufoff, gbase, voff)                                                                                       \
  do {                                                                                                                   \
    _Pragma("unroll") for (int _i = 0; _i < 2; ++_i) __builtin_amdgcn_global_load_lds(                                   \
        (const unsigned*)((const char*)(gbase) + (voff)[_i]), (LAS unsigned*)(lds + (bufoff) + ldsw + _i * 8192), 16, 0, 0); \
  } while (0)
#define LDA(dst, b, h)                                                                                                   \
  do {                                                                                                                   \
    _Pragma("unroll") for (int m = 0; m < 4; ++m) _Pragma("unroll") for (int k = 0; k < 2; ++k) dst[m][k] =              \
        *(const LAS bf16x8*)(lds + SA_(b, h) + aoff + m * 2048 + k * 1024);                                              \
  } while (0)
#define LDB(dst, b, h)                                                                                                   \
  do {                                                                                                                   \
    _Pragma("unroll") for (int n = 0; n < 2; ++n) _Pragma("unroll") for (int k = 0; k < 2; ++k) dst[n][k] =              \
        *(const LAS bf16x8*)(lds + SB_(b, h) + boff + n * 2048 + k * 1024);                                              \
  } while (0)
#define MMA0(ai, Bf) mma_blk<true>(acc[ai][0], At, Bf)
#define MMA1(ai, Bf) mma_blk<!VT1>(acc[ai][1], At, Bf)
#define WAIT_V(n) asm volatile("s_waitcnt vmcnt(" #n ")" ::: "memory")
#define WAIT_L(n) asm volatile("s_waitcnt lgkmcnt(" #n ")" ::: "memory")
#define BAR __builtin_amdgcn_s_barrier()
#define SCHED __builtin_amdgcn_sched_barrier(0)
#define KT(p, t) ((p) + (size_t)(t) * 128)
  STAGE(SB_(0, 0), cB, voffB); STAGE(SA_(0, 0), cA, voffA); STAGE(SB_(0, 1), cB + hB, voffB); STAGE(SA_(0, 1), cA + hA, voffA);
  if (wr == 1) BAR;
  WAIT_V(4); BAR;
  STAGE(SB_(1, 0), KT(cB, 1), voffB); STAGE(SA_(1, 0), KT(cA, 1), voffA); STAGE(SB_(1, 1), KT(cB + hB, 1), voffB);
  WAIT_V(6); BAR;
  for (int t = 0; t < nt - 2; t += 2) {
    LDB(B0, 0, 0); SCHED; LDA(At, 0, 0); STAGE(SA_(1, 1), KT(cA + hA, t + 1), voffA);
    WAIT_L(8); BAR; WAIT_L(0); MMA0(0, B0); BAR; SCHED;
    LDB(B1, 0, 1); STAGE(SB_(0, 0), KT(cB, t + 2), voffB);
    BAR; WAIT_L(0); MMA1(0, B1); BAR;
    LDA(At, 0, 1); STAGE(SA_(0, 0), KT(cA, t + 2), voffA);
    BAR; WAIT_L(0); MMA0(1, B0); BAR; SCHED;
    STAGE(SB_(0, 1), KT(cB + hB, t + 2), voffB);
    WAIT_V(6); BAR; MMA1(1, B1); BAR;
    LDB(B0, 1, 0); SCHED; LDA(At, 1, 0); STAGE(SA_(0, 1), KT(cA + hA, t + 2), voffA);
    WAIT_L(8); BAR; WAIT_L(0); MMA0(0, B0); BAR; SCHED;
    LDB(B1, 1, 1); STAGE(SB_(1, 0), KT(cB, t + 3), voffB);
    BAR; WAIT_L(0); MMA1(0, B1); BAR;
    LDA(At, 1, 1); STAGE(SA_(1, 0), KT(cA, t + 3), voffA);
    BAR; WAIT_L(0); MMA0(1, B0); BAR; SCHED;
    STAGE(SB_(1, 1), KT(cB + hB, t + 3), voffB);
    WAIT_V(6); BAR; MMA1(1, B1); BAR;
  }
  {
    LDB(B0, 0, 0); LDA(At, 0, 0); STAGE(SA_(1, 1), KT(cA + hA, nt - 1), voffA);
    BAR; WAIT_L(0); MMA0(0, B0); BAR;
    LDB(B1, 0, 1); BAR; WAIT_L(0); MMA1(0, B1); BAR;
    LDA(At, 0, 1); WAIT_V(4); BAR; WAIT_L(0); MMA0(1, B0); MMA1(1, B1); BAR;
  }
  {
    LDB(B0, 1, 0); LDA(At, 1, 0); WAIT_V(2); BAR; WAIT_L(0); MMA0(0, B0); BAR;
    LDB(B1, 1, 1); WAIT_V(0); BAR; WAIT_L(0); MMA1(0, B1); BAR;
    LDA(At, 1, 1); BAR; WAIT_L(0); MMA0(1, B0); MMA1(1, B1); BAR;
  }
  if (wr == 0) BAR;
#undef STAGE
#undef LDA
#undef LDB
#undef MMA0
#undef MMA1
#undef KT
}

struct EpiIdx { int wr, wc, fr, fq; };
DEV EpiIdx epi_idx() {
  const int tid = otid();
  const int wid = tid >> 6, lane = tid & 63;
  return EpiIdx{wid >> 2, wid & 3, lane & 15, lane >> 4};
}
DEV u32x2 pack4(float a, float b, float c, float d) { return u32x2{cvtpk(a, b), cvtpk(c, d)}; }
DEV u32x4 gather8(u32x2 a, u32x2 b) {
  u32x4 r;
#pragma unroll
  for (int d = 0; d < 2; ++d) {
    auto s1 = __builtin_amdgcn_permlane32_swap(a[d], b[d], false, false);
    auto s2 = __builtin_amdgcn_permlane16_swap(s1[0], s1[1], false, false);
    r[d] = s2[0];
    r[2 + d] = s2[1];
  }
  return r;
}

DEV void conv_tile(const float* __restrict__ src, const float* __restrict__ gain, bf16_t* __restrict__ dst, int K, int N, int ntn, int rope_mode,
                   int lt, char* smem) {
  const int k0 = (lt / ntn) * 64, n0 = (lt % ntn) * 64;
  float* tl = (float*)smem;
  const int tid = otid();
  __syncthreads();
  if (n0 < N) {
#pragma unroll
    for (int i = 0; i < 2; ++i) {
      const int k = (tid >> 4) + 32 * i, n = (tid & 15) * 4;
      f32x4 v = *(const f32x4*)(src + (size_t)(k0 + k) * N + n0 + n);
      const float g = gain ? gain[k0 + k] : 1.f;
      tl[k * 65 + n + 0] = v[0] * g;
      tl[k * 65 + n + 1] = v[1] * g;
      tl[k * 65 + n + 2] = v[2] * g;
      tl[k * 65 + n + 3] = v[3] * g;
    }
  }
  __syncthreads();
  const int n = tid >> 3, kc = (tid & 7) * 8;
  const bool rope = (rope_mode == 1 && n0 == 640) || (rope_mode == 2 && (n0 % 192) == 128);
  const int nn = rope ? ((n & 1) * 32 + (n >> 1)) : n;
  u32x4 o0;
  if (n0 < N) {
    float v[8];
#pragma unroll
    for (int q = 0; q < 8; ++q) v[q] = tl[(kc + q) * 65 + nn];
    o0 = u32x4{cvtpk(v[0], v[1]), cvtpk(v[2], v[3]), cvtpk(v[4], v[5]), cvtpk(v[6], v[7])};
  } else {
    o0 = u32x4{0, 0, 0, 0};
  }
  *(u32x4*)(dst + (size_t)(n0 + n) * K + k0 + kc) = o0;
}

DEV int t5_bucket(int rel) {
  const int ret = rel > 0 ? 16 : 0;
  const int n = rel < 0 ? -rel : rel;
  int large = 8 + (n >= 12) + (n >= 16) + (n >= 23) + (n >= 32) + (n >= 46) + (n >= 64) + (n >= 91);
  return ret + (n < 8 ? n : large);
}

DEV void sincos_d(float angf, float& sn, float& cs) {
  const double a = (double)angf;
  const double n = rint(a * 0.63661977236758134308);
  const double r = (a - n * 1.57079632679489655800) - n * 6.12323399573676603587e-17;
  const double r2 = r * r;
  double sp = -1.0 / 6227020800.0;
  sp = sp * r2 + 1.0 / 39916800.0;
  sp = sp * r2 - 1.0 / 362880.0;
  sp = sp * r2 + 1.0 / 5040.0;
  sp = sp * r2 - 1.0 / 120.0;
  sp = sp * r2 + 1.0 / 6.0;
  const double sr = r - r * r2 * sp;
  double cp = 1.0 / 87178291200.0;
  cp = cp * r2 - 1.0 / 479001600.0;
  cp = cp * r2 + 1.0 / 3628800.0;
  cp = cp * r2 - 1.0 / 40320.0;
  cp = cp * r2 + 1.0 / 720.0;
  cp = cp * r2 - 1.0 / 24.0;
  cp = cp * r2 + 0.5;
  const double cr = 1.0 - r2 * cp;
  const int q = ((int)n) & 3;
  const double s_ = (q & 1) ? cr : sr, c_ = (q & 1) ? sr : cr;
  sn = (float)((q & 2) ? -s_ : s_);
  cs = (float)(((q + 1) & 2) ? -c_ : c_);
}

DEV void phase0(const Params& p, int vb, int nb, char* smem) {
  const int tid = otid();
#define CONV_JOB(SRC, GAIN, DSTOFF, KK, NN, NPAD, RM)                                                        \
  {                                                                                                          \
    const float* jsrc = (SRC);                                                                               \
    const float* jgain = (GAIN);                                                                             \
    bf16_t* jdst = (bf16_t*)(p.ws + (DSTOFF));                                                               \
    constexpr int jntn = (NPAD) / 64;                                                                        \
    constexpr int jnt = ((KK) / 64) * jntn;                                                                  \
    for (int t = vb; t < jnt; t += nb) conv_tile(jsrc, jgain, jdst, (KK), (NN), jntn, (RM), t, smem);        \
  }
  for (int l = 0; l < 2; ++l) {
    CONV_JOB(p.in[1] + (size_t)l * 1024 * 1728, (l == 1 ? p.in[12] : (const float*)nullptr), OFF_WT_IN_A + l * SZ_WT_IN_A, 1024, 1728, 1792, 1)
    CONV_JOB(p.in[4] + (size_t)l * 384 * 1536, p.in[2] + l * 384, OFF_WT_UQ + l * SZ_WT_UQ, 384, 1536, 1536, 2)
    CONV_JOB(p.in[5] + (size_t)l * 256 * 2048, p.in[3] + l * 256, OFF_WT_UKV + l * SZ_WT_UKV, 256, 2048, 2048, 0)
    CONV_JOB(p.in[6] + (size_t)l * 1024 * 1024, nullptr, OFF_WT_O_A + l * SZ_WT_O, 1024, 1024, 1024, 0)
    CONV_JOB(p.in[10] + (size_t)l * 1024 * 1024, nullptr, OFF_WT_O_B + l * SZ_WT_O, 1024, 1024, 1024, 0)
  }
  CONV_JOB(p.in[8], p.in[12] + 1024, OFF_WT_IN_B0, 1024, 2048, 2048, 0)
  CONV_JOB(p.in[7], p.in[12] + 1024, OFF_WT_IN_B0 + (size_t)2048 * 1024 * 2, 1024, 256, 256, 0)
  CONV_JOB(p.in[8] + (size_t)1024 * 2048, p.in[12] + 2048, OFF_WT_IN_B1, 1024, 2048, 2048, 0)
#undef CONV_JOB
  {
    float* pcs = (float*)(p.ws + OFF_PART);
    float* pbw = pcs + 16 * 6144;
    for (int it = vb * NTHR + tid; it < 16 * 6144; it += nb * NTHR) {
      const int kc = it / 6144, n = it - kc * 6144;
      const float* W; int ldw, col, ln; bool valid = true;
      if (n < 1792) {
        W = p.in[1] + (size_t)1024 * 1728; ldw = 1728; ln = 0; col = n;
        if (n >= 640 && n < 704) { const int q = n - 640; col = 640 + (q & 1) * 32 + (q >> 1); }
        valid = n < 1728;
      } else if (n < 4096) {
        const int c = n - 1792; ln = 1;
        if (c < 2048) { W = p.in[8]; ldw = 2048; col = c; } else { W = p.in[7]; ldw = 256; col = c - 2048; }
      } else {
        W = p.in[8] + (size_t)1024 * 2048; ldw = 2048; ln = 2; col = n - 4096;
      }
      float scs = 0.f, sbw = 0.f;
      if (valid) {
        const float* g = p.in[12] + ln * 1024 + kc * 64;
        const float* bb = p.in[13] + ln * 1024 + kc * 64;
        const float* wp = W + (size_t)(kc * 64) * ldw + col;
#pragma unroll 8
        for (int k = 0; k < 64; ++k) {
          const float wv = wp[(size_t)k * ldw];
          scs += bf2f(f2bf(wv * g[k]));
          sbw += wv * bb[k];
        }
      }
      pcs[it] = scs;
      pbw[it] = sbw;
    }
  }
  {
    bf16_t* xb = (bf16_t*)(p.ws + OFF_XB);
    const size_t n8 = (size_t)T_TOK * DM / 8;
    for (size_t i = (size_t)vb * NTHR + tid; i < n8; i += (size_t)nb * NTHR) {
      f32x4 a = *(const f32x4*)(p.in[0] + i * 8);
      f32x4 b = *(const f32x4*)(p.in[0] + i * 8 + 4);
      *(u32x4*)(xb + i * 8) = u32x4{cvtpk(a[0], a[1]), cvtpk(a[2], a[3]), cvtpk(b[0], b[1]), cvtpk(b[2], b[3])};
    }
  }
  {
    float* ct = (float*)(p.ws + OFF_COS);
    float* st = (float*)(p.ws + OFF_SIN);
    for (int i = vb * NTHR + tid; i < SEQ * 32; i += nb * NTHR) {
      const int pos = i >> 5, j = i & 31;
      double invd = 1.0;
      for (int q = 0; q < j; ++q) invd *= 0.74989420933245582730;
      const float ang = (float)pos * (float)invd;
      float sn, cs;
      sincos_d(ang, sn, cs);
      ct[i] = cs;
      st[i] = sn;
    }
  }
  if (vb == 0) {
    float* bt = (float*)(p.ws + OFF_BIAS);
    for (int i = tid; i < 16 * 256; i += NTHR) {
      const int h = i >> 8, idx = i & 255;
      const int rel = idx - 191;
      bt[i] = p.in[11][t5_bucket(rel) * 16 + h] * LOG2E;
    }
    int* cnt = (int*)(p.ws + OFF_CNT);
    for (int i = tid; i < 1024; i += NTHR) cnt[i] = 0;
  }
}

DEV u32x2 rope4(const float* ct, const float* st, int pos, int jj, float v0, float v1, float v2, float v3) {
  const float2 cc = *(const float2*)(ct + pos * 32 + jj), ss = *(const float2*)(st + pos * 32 + jj);
  const float c0 = cc.x, s0 = ss.x, c1 = cc.y, s1 = ss.y;
  return pack4(v0 * c0 - v1 * s0, v1 * c0 + v0 * s0, v2 * c1 - v3 * s1, v3 * c1 + v2 * s1);
}

PHASE_FN void fold_reduce(char* ws, int vb, int nb) {
  const int tid = otid();
  const float* pcs = (const float*)(ws + OFF_PART);
  float* cs = (float*)(ws + OFF_CSBW);
  for (int n = vb * NTHR + tid; n < 2 * 6144; n += nb * NTHR) {
    const int a = n / 6144, c = n - a * 6144;
    float acc = 0.f;
#pragma unroll
    for (int kc = 0; kc < 16; ++kc) acc += pcs[(a * 16 + kc) * 6144 + c];
    cs[n] = acc;
  }
}

PHASE_FN void ln_stats(char* ws, int lprev, int m0, char* smem) {
  const int tid = otid();
  const int row = tid >> 1, half = tid & 1;
  const float* ps = (const float*)(ws + OFF_PSUM) + (size_t)(m0 + row) * 8 + half * 4;
  const f32x4 v = *(const f32x4*)ps;
  float sm = v[0] + v[2], sq = v[1] + v[3];
  sm += __shfl_xor(sm, 1);
  sq += __shfl_xor(sq, 1);
  const float mean = sm * (1.f / 1024.f);
  const float var = fmaxf(sq * (1.f / 1024.f) - mean * mean, 0.f);
  const float rstd = rsqrtf(var + EPS);
  float* rs = (float*)(smem + GEMM_LDS);
  __syncthreads();
  if (half == 0) {
    rs[row] = mean;
    rs[256 + row] = rstd;
    float* st = (float*)(ws + OFF_STATS) + ((size_t)lprev * T_TOK + m0 + row) * 2;
    st[0] = mean;
    st[1] = rstd;
  }
  __syncthreads();
}

PHASE_FN void p1_tile(char* ws, int layer, int tile, char* smem) {
  const int mt = tile / 7, nt = tile % 7;
  const int brow = mt * 256, bcol = nt * 256;
  const bf16_t* A = (const bf16_t*)(ws + OFF_XB);
  const bf16_t* Bt = (const bf16_t*)(ws + OFF_WT_IN_A + layer * SZ_WT_IN_A);
  f32x4 acc[2][2][4][2];
  gemm256<false>(A, 1024, Bt, 1024, 1024, brow, bcol, (LAS unsigned char*)smem, acc);
  const EpiIdx e = epi_idx();
  bf16_t* cq = (bf16_t*)(ws + OFF_CQKV);
  bf16_t* kr = (bf16_t*)(ws + OFF_KROPE);
  bf16_t* sg = (bf16_t*)(ws + OFF_SGATE);
  const float* ct = (const float*)(ws + OFF_COS);
  const float* st = (const float*)(ws + OFF_SIN);
#pragma unroll
  for (int bj = 0; bj < 2; ++bj) {
    const int cb = bcol + bj * 128 + e.wc * 32;
    if (cb >= 1728) continue;
    f32x4 c4h[2], b4h[2];
    if (layer == 1) {
#pragma unroll
      for (int n = 0; n < 2; ++n) {
        c4h[n] = *(const f32x4*)((const float*)(ws + OFF_CSBW) + cb + n * 16 + e.fq * 4);
        b4h[n] = *(const f32x4*)((const float*)(ws + OFF_CSBW) + 6144 + cb + n * 16 + e.fq * 4);
      }
    }
#pragma unroll
    for (int ai = 0; ai < 2; ++ai)
#pragma unroll
      for (int m = 0; m < 4; ++m)
        {
          const int rl = ai * 128 + e.wr * 64 + m * 16 + e.fr;
          const int row = brow + rl;
          u32x2 pk[2];
#pragma unroll
          for (int n = 0; n < 2; ++n) {
            const int col0 = cb + n * 16 + e.fq * 4;
            f32x4 v = acc[ai][bj][m][n];
            if (layer == 1) {
              const float* rs = (const float*)(smem + GEMM_LDS);
              const float mean = rs[rl], rstd = rs[256 + rl];
#pragma unroll
              for (int q = 0; q < 4; ++q) v[q] = rstd * (v[q] - mean * c4h[n][q]) + b4h[n][q];
            }
            if (cb < 640) pk[n] = pack4(v[0], v[1], v[2], v[3]);
            else if (cb < 704) pk[n] = rope4(ct, st, row & (SEQ - 1), (col0 - 640) >> 1, v[0], v[1], v[2], v[3]);
            else pk[n] = pack4(silu(v[0]), silu(v[1]), silu(v[2]), silu(v[3]));
          }
          const u32x4 w8 = gather8(pk[0], pk[1]);
          const int c8 = cb + e.fq * 8;
          if (cb < 640) *(u32x4*)(cq + (size_t)row * 640 + c8) = w8;
          else if (cb < 704) *(u32x4*)(kr + (size_t)row * 64 + (c8 - 640)) = w8;
          else *(u32x4*)(sg + (size_t)row * 1024 + (c8 - 704)) = w8;
        }
  }
}

PHASE_FN void p2_rowscale(char* ws, int m0, char* smem) {
  const int tid = otid();
  const int row = tid >> 1, half = tid & 1;
  const bf16_t* c = (const bf16_t*)(ws + OFF_CQKV) + (size_t)(m0 + row) * 640;
  float sq = 0.f, sk = 0.f;
#pragma unroll 4
  for (int i = 0; i < 24; ++i) {
    u32x4 v = *(const u32x4*)(c + half * 192 + i * 8);
#pragma unroll
    for (int e = 0; e < 4; ++e) {
      float a = __uint_as_float(v[e] << 16), b = __uint_as_float(v[e] & 0xffff0000u);
      sq += a * a + b * b;
    }
  }
#pragma unroll 4
  for (int i = 0; i < 16; ++i) {
    u32x4 v = *(const u32x4*)(c + 384 + half * 128 + i * 8);
#pragma unroll
    for (int e = 0; e < 4; ++e) {
      float a = __uint_as_float(v[e] << 16), b = __uint_as_float(v[e] & 0xffff0000u);
      sk += a * a + b * b;
    }
  }
  sq += __shfl_xor(sq, 1);
  sk += __shfl_xor(sk, 1);
  float* rs = (float*)(smem + GEMM_LDS);
  __syncthreads();
  if (half == 0) {
    rs[row] = rsqrtf(sq * (1.f / 384.f) + EPS);
    rs[256 + row] = rsqrtf(sk * (1.f / 256.f) + EPS);
  }
  __syncthreads();
}

PHASE_FN void p2_tile(char* ws, int layer, int mt, int nt, char* smem) {
  const int brow = mt * 256;
  const float* rs = (const float*)(smem + GEMM_LDS);
  const bf16_t* A = (const bf16_t*)(ws + OFF_CQKV);
  f32x4 acc[2][2][4][2];
  if (nt < 6) {
    const int bcol = nt * 256;
    const bf16_t* Bt = (const bf16_t*)(ws + OFF_WT_UQ + layer * SZ_WT_UQ);
    gemm256<false>(A, 640, Bt, 384, 384, brow, bcol, (LAS unsigned char*)smem, acc);
    const EpiIdx e = epi_idx();
    bf16_t* q = (bf16_t*)(ws + OFF_Q);
    const float* ct = (const float*)(ws + OFF_COS);
    const float* st = (const float*)(ws + OFF_SIN);
#pragma unroll
    for (int bj = 0; bj < 2; ++bj) {
      const int cb = bcol + bj * 128 + e.wc * 32;
      const int hc = cb % 192;
      const bool is_rope = hc >= 128;
#pragma unroll
      for (int ai = 0; ai < 2; ++ai)
#pragma unroll
        for (int m = 0; m < 4; ++m) {
          const int rl = ai * 128 + e.wr * 64 + m * 16 + e.fr;
          const int row = brow + rl;
          const float sc = rs[rl] * QSCALE_A;
          u32x2 pk[2];
#pragma unroll
          for (int n = 0; n < 2; ++n) {
            const f32x4 v = acc[ai][bj][m][n];
            if (is_rope) pk[n] = rope4(ct, st, row & (SEQ - 1), (hc - 128 + n * 16 + e.fq * 4) >> 1, v[0] * sc, v[1] * sc, v[2] * sc, v[3] * sc);
            else pk[n] = pack4(v[0] * sc, v[1] * sc, v[2] * sc, v[3] * sc);
          }
          *(u32x4*)(q + (size_t)row * 1536 + cb + e.fq * 8) = gather8(pk[0], pk[1]);
        }
    }
  } else {
    const int head = nt - 6;
    const int bcol = head * 256;
    const bf16_t* Bt = (const bf16_t*)(ws + OFF_WT_UKV + layer * SZ_WT_UKV);
    gemm256<true>(A + 384, 640, Bt, 256, 256, brow, bcol, (LAS unsigned char*)smem, acc);
    const EpiIdx e = epi_idx();
    bf16_t* kn = (bf16_t*)(ws + OFF_KN);
    bf16_t* vt = (bf16_t*)(ws + OFF_VT);
    const int b = brow >> 13;
#pragma unroll
    for (int ai = 0; ai < 2; ++ai)
#pragma unroll
      for (int m = 0; m < 4; ++m) {
        {
          const int rl = ai * 128 + e.wr * 64 + m * 16 + e.fr;
          const float sc = rs[256 + rl];
          u32x2 pk[2];
#pragma unroll
          for (int n = 0; n < 2; ++n) {
            const f32x4 v = acc[ai][0][m][n];
            pk[n] = pack4(v[0] * sc, v[1] * sc, v[2] * sc, v[3] * sc);
          }
          *(u32x4*)(kn + (size_t)(brow + rl) * 1024 + head * 128 + e.wc * 32 + e.fq * 8) = gather8(pk[0], pk[1]);
        }
        if ((m & 1) == 0) {
          const int rl0 = ai * 128 + e.wr * 64 + m * 16 + e.fq * 4;
          const f32x4 sc0 = *(const f32x4*)(rs + 256 + rl0), sc1 = *(const f32x4*)(rs + 256 + rl0 + 16);
          const int s8 = (brow + ai * 128 + e.wr * 64 + m * 16 + e.fq * 8) & (SEQ - 1);
#pragma unroll
          for (int n = 0; n < 2; ++n) {
            const f32x4 v0 = acc[ai][1][m][n], v1 = acc[ai][1][m + 1][n];
            const int d = e.wc * 32 + n * 16 + e.fr;
            *(u32x4*)(vt + ((size_t)((b * 8 + head) * 128 + d)) * SEQ + s8) =
                gather8(pack4(v0[0] * sc0[0], v0[1] * sc0[1], v0[2] * sc0[2], v0[3] * sc0[3]),
                        pack4(v1[0] * sc1[0], v1[1] * sc1[1], v1[2] * sc1[2], v1[3] * sc1[3]));
          }
        }
      }
  }
}

PHASE_FN void pout_tile(char* ws, float* out, const float* x, const float* ln_gain, const float* ln_bias, int layer, int tile, char* smem) {
  const int mt = tile >> 2, nt = tile & 3;
  const int brow = mt * 256, bcol = nt * 256;
  const bf16_t* A = (const bf16_t*)(ws + OFF_OG);
  const bf16_t* Bt = (const bf16_t*)(ws + (layer < 2 ? OFF_WT_O_A + layer * SZ_WT_O : OFF_WT_O_B + (layer - 2) * SZ_WT_O));
  f32x4 acc[2][2][4][2];
  gemm256<false>(A, 1024, Bt, 1024, 1024, brow, bcol, (LAS unsigned char*)smem, acc);
  const EpiIdx e = epi_idx();
  bf16_t* zb = (bf16_t*)(ws + OFF_XB);
  const float* stp = (const float*)(ws + OFF_STATS) + (size_t)(layer > 0 ? layer - 1 : 0) * T_TOK * 2;
  const float* g = ln_gain + (layer > 0 ? layer - 1 : 0) * 1024;
  const float* bt = ln_bias + (layer > 0 ? layer - 1 : 0) * 1024;
  float* red = (float*)smem;
  float smr[2][4], sqr[2][4];
#pragma unroll
  for (int ai = 0; ai < 2; ++ai)
#pragma unroll
    for (int m = 0; m < 4; ++m) { smr[ai][m] = 0.f; sqr[ai][m] = 0.f; }
#pragma unroll
  for (int bj = 0; bj < 2; ++bj) {
    f32x4 g4[2], b4[2];
    if (layer > 0) {
#pragma unroll
      for (int n = 0; n < 2; ++n) {
        const int col0 = bcol + bj * 128 + e.wc * 32 + n * 16 + e.fq * 4;
        g4[n] = *(const f32x4*)(g + col0);
        b4[n] = *(const f32x4*)(bt + col0);
      }
    }
#pragma unroll
    for (int ai = 0; ai < 2; ++ai)
#pragma unroll
      for (int m = 0; m < 4; ++m) {
        const int rl = ai * 128 + e.wr * 64 + m * 16 + e.fr;
        const int row = brow + rl;
        float mean = 0.f, rstd = 1.f;
        if (layer > 0) {
          const float2 st = *(const float2*)(stp + (size_t)row * 2);
          mean = st.x; rstd = st.y;
        }
        float sm = 0.f, sq = 0.f;
        u32x2 pk[2];
#pragma unroll
        for (int n = 0; n < 2; ++n) {
          const int col0 = bcol + bj * 128 + e.wc * 32 + n * 16 + e.fq * 4;
          const size_t idx = (size_t)row * 1024 + col0;
          f32x4 r;
          if (layer == 0) {
            r = *(const f32x4*)(x + idx);
          } else {
            const f32x4 zp = *(const f32x4*)(out + idx);
#pragma unroll
            for (int q = 0; q < 4; ++q) r[q] = (zp[q] - mean) * rstd * g4[n][q] + b4[n][q];
          }
          const f32x4 v = acc[ai][bj][m][n];
          f32x4 z;
#pragma unroll
          for (int q = 0; q < 4; ++q) { z[q] = DN_ALPHA * r[q] + v[q]; sm += z[q]; sq += z[q] * z[q]; }
          *(f32x4*)(out + idx) = z;
          pk[n] = pack4(z[0], z[1], z[2], z[3]);
        }
        const u32x4 w8 = gather8(pk[0], pk[1]);
        if (layer < 3) *(u32x4*)(zb + (size_t)row * 1024 + bcol + bj * 128 + e.wc * 32 + e.fq * 8) = w8;
        smr[ai][m] += sm;
        sqr[ai][m] += sq;
      }
  }
#pragma unroll
  for (int ai = 0; ai < 2; ++ai)
#pragma unroll
    for (int m = 0; m < 4; ++m) {
      const int rl = ai * 128 + e.wr * 64 + m * 16 + e.fr;
      float sm = smr[ai][m], sq = sqr[ai][m];
      sm += __shfl_xor(sm, 16); sq += __shfl_xor(sq, 16);
      sm += __shfl_xor(sm, 32); sq += __shfl_xor(sq, 32);
      if (e.fq == 0) { red[(e.wc * 256 + rl) * 2] = sm; red[(e.wc * 256 + rl) * 2 + 1] = sq; }
    }
  __syncthreads();
  {
    const int tid = otid();
    if (tid < 256) {
      float sm = 0.f, sq = 0.f;
#pragma unroll
      for (int c = 0; c < 4; ++c) { sm += red[(c * 256 + tid) * 2]; sq += red[(c * 256 + tid) * 2 + 1]; }
      float* ps = (float*)(ws + OFF_PSUM) + (size_t)(brow + tid) * 8 + nt * 2;
      ps[0] = sm;
      ps[1] = sq;
    }
  }
  __syncthreads();
}

template <bool KVT>
PHASE_FN void p5_tile(char* ws, int brow, int bcol, const bf16_t* Bt, int cbase, char* smem) {
  const bf16_t* A = (const bf16_t*)(ws + OFF_XB);
  f32x4 acc[2][2][4][2];
  gemm256<KVT>(A, 1024, Bt, 1024, 1024, brow, bcol, (LAS unsigned char*)smem, acc);
  const EpiIdx e = epi_idx();
  if (!KVT) {
    bf16_t* q = (bf16_t*)(ws + OFF_Q);
    bf16_t* sg = (bf16_t*)(ws + OFF_SGATE);
#pragma unroll
    for (int bj = 0; bj < 2; ++bj) {
      f32x4 c4[2], b4[2];
#pragma unroll
      for (int n = 0; n < 2; ++n) {
        const int col0 = bcol + bj * 128 + e.wc * 32 + n * 16 + e.fq * 4;
        c4[n] = *(const f32x4*)((const float*)(ws + OFF_CSBW) + cbase + col0);
        b4[n] = *(const f32x4*)((const float*)(ws + OFF_CSBW) + 6144 + cbase + col0);
      }
#pragma unroll
      for (int ai = 0; ai < 2; ++ai)
#pragma unroll
        for (int m = 0; m < 4; ++m) {
          const int rl = ai * 128 + e.wr * 64 + m * 16 + e.fr;
          const int row = brow + rl;
          u32x2 pk[2];
#pragma unroll
          for (int n = 0; n < 2; ++n) {
            f32x4 v = acc[ai][bj][m][n];
            {
              const float* rs = (const float*)(smem + GEMM_LDS);
              const float mean = rs[rl], rstd = rs[256 + rl];
#pragma unroll
              for (int qq = 0; qq < 4; ++qq) v[qq] = rstd * (v[qq] - mean * c4[n][qq]) + b4[n][qq];
            }
            if (bcol < 1024) pk[n] = pack4(v[0] * QSCALE_B, v[1] * QSCALE_B, v[2] * QSCALE_B, v[3] * QSCALE_B);
            else pk[n] = pack4(silu(v[0]), silu(v[1]), silu(v[2]), silu(v[3]));
          }
          const u32x4 w8 = gather8(pk[0], pk[1]);
          const int c8 = bcol + bj * 128 + e.wc * 32 + e.fq * 8;
          if (bcol < 1024) *(u32x4*)(q + (size_t)row * 1024 + c8) = w8;
          else *(u32x4*)(sg + (size_t)row * 1024 + (c8 - 1024)) = w8;
        }
    }
  } else {
    bf16_t* kb = (bf16_t*)(ws + OFF_KN);
    bf16_t* vt = (bf16_t*)(ws + OFF_VT);
    const int b = brow >> 13;
#pragma unroll
    for (int ai = 0; ai < 2; ++ai)
#pragma unroll
      for (int m = 0; m < 4; ++m)
#pragma unroll
        for (int n = 0; n < 2; ++n) {
          const float* rs = (const float*)(smem + GEMM_LDS);
          const float* csb = (const float*)(ws + OFF_CSBW) + cbase + 2048;
          {
            const int rl = ai * 128 + e.wr * 64 + m * 16 + e.fr;
            const int row = brow + rl;
            const int c0 = e.wc * 32 + n * 16 + e.fq * 4;
            const float mean = rs[rl], rstd = rs[256 + rl];
            const f32x4 c4 = *(const f32x4*)(csb + c0);
            const f32x4 b4 = *(const f32x4*)(csb + 6144 + c0);
            f32x4 v = acc[ai][0][m][n];
#pragma unroll
            for (int qq = 0; qq < 4; ++qq) v[qq] = rstd * (v[qq] - mean * c4[qq]) + b4[qq];
            *(u32x2*)(kb + (size_t)row * 128 + c0) = pack4(v[0], v[1], v[2], v[3]);
          }
          {
            const int rl = ai * 128 + e.wr * 64 + m * 16 + e.fq * 4;
            const int s = (brow + rl) & (SEQ - 1);
            const int d = e.wc * 32 + n * 16 + e.fr;
            const f32x4 mean4 = *(const f32x4*)(rs + rl), rstd4 = *(const f32x4*)(rs + 256 + rl);
            const float cc = csb[128 + d], bbv = csb[6144 + 128 + d];
            f32x4 v = acc[ai][1][m][n];
#pragma unroll
            for (int qq = 0; qq < 4; ++qq) v[qq] = rstd4[qq] * (v[qq] - mean4[qq] * cc) + bbv;
            *(u32x2*)(vt + ((size_t)((b * 2 + (d >> 6)) * 64 + (d & 63))) * SEQ + s) = pack4(v[0], v[1], v[2], v[3]);
          }
        }
  }
}

PHASE_FN void ln_phase(char* ws, float* out, const float* ln_gain, const float* ln_bias, int layer, int vb, int nb) {
  const int tid_ = otid();
  const int lane = tid_ & 63, wave = tid_ >> 6;
  const float* g = ln_gain + layer * 1024;
  const float* bta = ln_bias + layer * 1024;
  f32x4 gg[4], bb[4];
#pragma unroll
  for (int i = 0; i < 4; ++i) {
    gg[i] = *(const f32x4*)(g + i * 256 + lane * 4);
    bb[i] = *(const f32x4*)(bta + i * 256 + lane * 4);
  }
  for (int row = vb * NWAVE + wave; row < T_TOK; row += nb * NWAVE) {
    float* zr = out + (size_t)row * 1024;
    f32x4 v[4];
    float s = 0.f;
#pragma unroll
    for (int i = 0; i < 4; ++i) {
      v[i] = *(const f32x4*)(zr + i * 256 + lane * 4);
      s += v[i][0] + v[i][1] + v[i][2] + v[i][3];
    }
    const float mean = wave_sum(s) * (1.f / 1024.f);
    float q = 0.f;
#pragma unroll
    for (int i = 0; i < 4; ++i)
#pragma unroll
      for (int e = 0; e < 4; ++e) {
        const float d = v[i][e] - mean;
        q += d * d;
      }
    const float rstd = rsqrtf(wave_sum(q) * (1.f / 1024.f) + EPS);
#pragma unroll
    for (int i = 0; i < 4; ++i) {
      f32x4 y;
#pragma unroll
      for (int e = 0; e < 4; ++e) y[e] = (v[i][e] - mean) * rstd * gg[i][e] + bb[i][e];
      *(f32x4*)(zr + i * 256 + lane * 4) = y;
    }
  }
}

template <int CH>
DEV unsigned piece_off(int p, int lane, int src_row_bytes) {
  const int g = 64 * p + lane;
  const int row = g / CH;
  int c = g - row * CH;
  if (c == CH - 1) c = CH - 2;
  return (unsigned)(row * src_row_bytes + c * 16);
}
DEV void glds16(const char* src, LAS unsigned char* dst) {
#ifdef DEBUG_NO_DMA
  const u32x4 v = *(const u32x4*)src;
  *(LAS u32x4*)(dst + (threadIdx.x & 63) * 16) = v;
#else
  __builtin_amdgcn_global_load_lds((const unsigned*)src, (LAS unsigned*)dst, 16, 0, 0);
#endif
}

template <bool MLA>
PHASE_FN void attn_item(char* ws, const float* sinks, int layer, int item, char* smem) {
  constexpr int DQK = MLA ? 192 : 64;
  constexpr int DV = MLA ? 128 : 64;
  constexpr int NROW = MLA ? 272 : 144;
  constexpr int RROW = 144;
  constexpr int VROW = 144;
  constexpr int NKS = DQK / 16;
  constexpr int NDB = DV / 32;
  constexpr int KN_BYTES = 64 * NROW;
  constexpr int K_BYTES = MLA ? KN_BYTES + 64 * RROW : KN_BYTES;
  constexpr int V_BYTES = DV * VROW;
  constexpr float THR = 6.f;
  constexpr int NBUF = 3;

  item = __builtin_amdgcn_readfirstlane(item);
  const int tid = otid(), lane = tid & 63;
  const int wu = __builtin_amdgcn_readfirstlane(tid >> 6);
  const int w = wu;
  const int h = lane >> 5, l31 = lane & 31;
  LAS unsigned char* lds = (LAS unsigned char*)smem;
  float* bias_s = (float*)(smem + NBUF * K_BYTES + NBUF * V_BYTES);

  int b, hd, qrow0, tile0, nt_blk, nt_mine;
  int hq = 0, cq = 0;
  if (MLA) {
    b = item >> 8;
    hd = (item >> 5) & 7;
    const int i = item & 31;
    qrow0 = b * SEQ + 256 * i + 32 * w;
    tile0 = 0;
    nt_blk = 4 * i + 4;
    nt_mine = 4 * i + 1 + (w >> 1);
  } else {
    const int sub = item & 1;
    cq = (item >> 1) & 127;
    hd = (item >> 8) & 1;
    b = item >> 9;
    hq = hd * 8 + sub * 4 + (w >> 1);
    qrow0 = b * SEQ + 64 * cq + 32 * (w & 1);
    tile0 = cq >= 2 ? cq - 2 : 0;
    nt_blk = cq - tile0 + 1;
    nt_mine = nt_blk;
  }

  bf16x8 qf[NKS];
  {
    const bf16_t* qp = (const bf16_t*)(ws + OFF_Q);
    const bf16_t* src = MLA ? qp + (size_t)(qrow0 + l31) * 1536 + hd * 192 + h * 8
                            : qp + (size_t)(qrow0 + l31) * 1024 + hq * 64 + h * 8;
#pragma unroll
    for (int ks = 0; ks < NKS; ++ks) qf[ks] = *(const bf16x8*)(src + ks * 16);
  }

  const char* kbase = MLA ? (const char*)(ws + OFF_KN) + ((size_t)b * SEQ + (size_t)tile0 * 64) * 2048 + hd * 256
                          : (const char*)(ws + OFF_KN) + ((size_t)b * SEQ + (size_t)tile0 * 64) * 256 + hd * 128;
  const char* rbase = (const char*)(ws + OFF_KROPE) + ((size_t)b * SEQ + (size_t)tile0 * 64) * 128;
  const char* vbase = MLA ? (const char*)(ws + OFF_VT) + ((size_t)(b * 8 + hd) * 128) * (SEQ * 2) + (size_t)tile0 * 128
                          : (const char*)(ws + OFF_VT) + ((size_t)(b * 2 + hd) * 64) * (SEQ * 2) + (size_t)tile0 * 128;
  unsigned po0, po1, po2 = 0, po3 = 0, po4 = 0, po5 = 0;
  if (MLA) {
    po0 = piece_off<17>(wu, lane, 2048);
    po1 = piece_off<17>(wu + 8, lane, 2048);
    po2 = piece_off<9>(wu, lane, 128);
    po3 = piece_off<9>(wu, lane, SEQ * 2);
    po4 = piece_off<9>(wu + 8, lane, SEQ * 2);
    po5 = wu == 0 ? piece_off<17>(16, lane, 2048) : wu == 1 ? piece_off<9>(8, lane, 128) : piece_off<9>(wu == 2 ? 16 : 17, lane, SEQ * 2);
  } else {
    po0 = piece_off<9>(wu, lane, 256);
    po1 = piece_off<9>(wu, lane, SEQ * 2);
    po5 = wu == 0 ? piece_off<9>(8, lane, 256) : piece_off<9>(8, lane, SEQ * 2);
  }
  auto issue_k = [&](int tj, int slot) {
    LAS unsigned char* img = lds + slot * K_BYTES;
    if (MLA) {
      const char* kb = kbase + (size_t)tj * (64 * 2048);
      const char* rb = rbase + (size_t)tj * (64 * 128);
      glds16(kb + po0, img + wu * 1024);
      glds16(kb + po1, img + (wu + 8) * 1024);
      glds16(rb + po2, img + KN_BYTES + wu * 1024);
      if (wu == 0) glds16(kb + po5, img + 16 * 1024);
      else if (wu == 1) glds16(rb + po5, img + KN_BYTES + 8 * 1024);
    } else {
      const char* kb = kbase + (size_t)tj * (64 * 256);
      glds16(kb + po0, img + wu * 1024);
      if (wu == 0) glds16(kb + po5, img + 8 * 1024);
    }
  };
  auto issue_v = [&](int tj, int slot) {
    LAS unsigned char* img = lds + NBUF * K_BYTES + slot * V_BYTES;
    const char* vb = vbase + (size_t)tj * 128;
    if (MLA) {
      glds16(vb + po3, img + wu * 1024);
      glds16(vb + po4, img + (wu + 8) * 1024);
      if (wu == 2 || wu == 3) glds16(vb + po5, img + (14 + wu) * 1024);
    } else {
      glds16(vb + po1, img + wu * 1024);
      if (wu == 1) glds16(vb + po5, img + 8 * 1024);
    }
  };
  const int sig = (l31 & 0x13) | ((l31 & 4) << 1) | ((l31 & 8) >> 1);
  const int kofs = sig * NROW + h * 16;
  const int rofs = KN_BYTES + sig * RROW + h * 16;
  const int vofs = NBUF * K_BYTES + l31 * VROW + h * 16;
  auto kfrag = [&](const char* Ks, int ks, int kb) -> bf16x8 {
    if (MLA && ks >= 8) return *(const bf16x8*)(Ks + rofs + kb * 32 * RROW + (ks - 8) * 32);
    return *(const bf16x8*)(Ks + kofs + kb * 32 * NROW + ks * 32);
  };
  auto qk_tile = [&](int slot, float init, f32x16& s0, f32x16& s1) {
    const char* Ks = smem + slot * K_BYTES;
#pragma unroll
    for (int r = 0; r < 16; ++r) { s0[r] = init; s1[r] = init; }
    bf16x8 ka[3][2];
    ka[0][0] = kfrag(Ks, 0, 0);
    ka[0][1] = kfrag(Ks, 0, 1);
    ka[1][0] = kfrag(Ks, 1, 0);
    ka[1][1] = kfrag(Ks, 1, 1);
#pragma unroll
    for (int ks = 0; ks < NKS; ++ks) {
      if (ks + 2 < NKS) {
        ka[(ks + 2) % 3][0] = kfrag(Ks, ks + 2, 0);
        ka[(ks + 2) % 3][1] = kfrag(Ks, ks + 2, 1);
      }
      s0 = __builtin_amdgcn_mfma_f32_32x32x16_bf16(ka[ks % 3][0], qf[ks], s0, 0, 0, 0);
      s1 = __builtin_amdgcn_mfma_f32_32x32x16_bf16(ka[ks % 3][1], qf[ks], s1, 0, 0, 0);
      __builtin_amdgcn_sched_barrier(0);
    }
  };

  float m_run, l_run;
  __syncthreads();
  issue_k(0, 0);
  issue_v(0, 0);
  if (nt_blk > 1) { issue_k(1, 1); issue_v(1, 1); }
  if (MLA) {
    m_run = 0.f;
    l_run = 0.f;
  } else {
    const float* bt = (const float*)(ws + OFF_BIAS);
    const int sub = item & 1;
    for (int i = tid; i < 1024; i += NTHR) bias_s[i] = bt[(hd * 8 + sub * 4 + (i >> 8)) * 256 + (i & 255)];
    m_run = sinks[(layer - 2) * 16 + hq] * LOG2E;
    l_run = (h == 0) ? 1.f : 0.f;
  }
  asm volatile("s_waitcnt vmcnt(0)" ::: "memory");
  __syncthreads();
  __syncthreads();

  f32x16 o[NDB];
#pragma unroll
  for (int db = 0; db < NDB; ++db)
#pragma unroll
    for (int r = 0; r < 16; ++r) o[db][r] = 0.f;

  auto bias_max = [&](int tj, f32x16& s0, f32x16& s1) -> float {
    if (!MLA) {
      const int kc = tile0 + tj;
      const int base = (kc - cq) * 64 - 32 * (w & 1) - l31 + 191 + 8 * h;
      const float* bs = bias_s + (w >> 1) * 256 + base;
#pragma unroll
      for (int r = 0; r < 16; ++r) {
        const int ko = 16 * (r >> 3) + 4 * ((r >> 2) & 1) + (r & 3);
        s0[r] += bs[ko];
        s1[r] += bs[32 + ko];
      }
    }
    float mx = s0[0];
#pragma unroll
    for (int r = 1; r < 16; ++r) mx = fmaxf(mx, s0[r]);
#pragma unroll
    for (int r = 0; r < 16; ++r) mx = fmaxf(mx, s1[r]);
    return swapmax(mx);
  };
  auto raise = [&](float mx, f32x16& s0, f32x16& s1) {
    if (!__all(mx <= THR)) {
      const float dlt = fmaxf(mx, 0.f);
      const float alpha = __builtin_amdgcn_exp2f(-dlt);
      m_run += dlt;
      l_run *= alpha;
#pragma unroll
      for (int db = 0; db < NDB; ++db)
#pragma unroll
        for (int r = 0; r < 16; ++r) o[db][r] *= alpha;
#pragma unroll
      for (int r = 0; r < 16; ++r) { s0[r] -= dlt; s1[r] -= dlt; }
    }
  };

  int slot = 0;
  for (int tj = 0; tj < nt_blk; ++tj) {
    if (tj + 2 < nt_blk) { const int s2 = (slot >= 1) ? slot - 1 : 2; issue_k(tj + 2, s2); issue_v(tj + 2, s2); }
    if (tj < nt_mine) {
      f32x16 c0, c1;
      qk_tile(slot, (MLA && tj == 0) ? 0.f : -m_run, c0, c1);
      const float mx = bias_max(tj, c0, c1);
      if (MLA && tj == 0) {
        m_run = mx;
#pragma unroll
        for (int r = 0; r < 16; ++r) { c0[r] -= mx; c1[r] -= mx; }
      } else {
        raise(mx, c0, c1);
      }
      float ps = 0.f;
#pragma unroll
      for (int r = 0; r < 16; ++r) {
        c0[r] = __builtin_amdgcn_exp2f(c0[r]);
        c1[r] = __builtin_amdgcn_exp2f(c1[r]);
        ps += c0[r] + c1[r];
      }
      l_run += ps;
      bf16x8 pb[4];
      {
        u32x4 t0 = {cvtpk(c0[0], c0[1]), cvtpk(c0[2], c0[3]), cvtpk(c0[4], c0[5]), cvtpk(c0[6], c0[7])};
        u32x4 t1 = {cvtpk(c0[8], c0[9]), cvtpk(c0[10], c0[11]), cvtpk(c0[12], c0[13]), cvtpk(c0[14], c0[15])};
        u32x4 t2 = {cvtpk(c1[0], c1[1]), cvtpk(c1[2], c1[3]), cvtpk(c1[4], c1[5]), cvtpk(c1[6], c1[7])};
        u32x4 t3 = {cvtpk(c1[8], c1[9]), cvtpk(c1[10], c1[11]), cvtpk(c1[12], c1[13]), cvtpk(c1[14], c1[15])};
        pb[0] = *(bf16x8*)&t0; pb[1] = *(bf16x8*)&t1; pb[2] = *(bf16x8*)&t2; pb[3] = *(bf16x8*)&t3;
      }
      const char* Vs = smem + slot * V_BYTES;
      bf16x8 va[2][4];
#pragma unroll
      for (int t = 0; t < 4; ++t) va[0][t] = *(const bf16x8*)(Vs + vofs + t * 32);
#pragma unroll
      for (int db = 0; db < NDB; ++db) {
        if (db + 1 < NDB) {
#pragma unroll
          for (int t = 0; t < 4; ++t) va[(db + 1) & 1][t] = *(const bf16x8*)(Vs + vofs + (db + 1) * 32 * VROW + t * 32);
        }
#pragma unroll
        for (int t = 0; t < 4; ++t) o[db] = __builtin_amdgcn_mfma_f32_32x32x16_bf16(va[db & 1][t], pb[t], o[db], 0, 0, 0);
      }
    }
    asm volatile("s_waitcnt vmcnt(0)" ::: "memory");
    __syncthreads();
    slot = (slot == 2) ? 0 : slot + 1;
  }

  const float inv = 1.f / swapsum(l_run);
  const int row = qrow0 + l31;
  const int colbase = MLA ? hd * 128 : hq * 64;
  const bf16_t* sg = (const bf16_t*)(ws + OFF_SGATE) + (size_t)row * 1024 + colbase;
  bf16_t* og = (bf16_t*)(ws + OFF_OG) + (size_t)row * 1024 + colbase;
#pragma unroll
  for (int db = 0; db < NDB; ++db)
#pragma unroll
    for (int k = 0; k < 2; ++k) {
      float ev[8];
#pragma unroll
      for (int j = 0; j < 4; ++j) {
        auto sw = __builtin_amdgcn_permlane32_swap(__float_as_uint(o[db][(2 * k) * 4 + j]), __float_as_uint(o[db][(2 * k + 1) * 4 + j]), false, false);
        ev[j] = __uint_as_float(sw[0]);
        ev[4 + j] = __uint_as_float(sw[1]);
      }
      const int d = 32 * db + 16 * k + 8 * h;
      const u32x4 gv = *(const u32x4*)(sg + d);
      u32x4 ov;
#pragma unroll
      for (int i = 0; i < 4; ++i) {
        const float g0 = __uint_as_float(gv[i] << 16), g1 = __uint_as_float(gv[i] & 0xffff0000u);
        ov[i] = cvtpk(ev[2 * i] * inv * g0, ev[2 * i + 1] * inv * g1);
      }
      *(u32x4*)(og + d) = ov;
    }
}

PHASE_FN void swa_phase(char* ws, const float* sinks, int layer, int vb, int nb, char* smem) {
  constexpr int TB = 9216;
  constexpr int BUFB = 6 * TB;
  constexpr float THR = 6.f;
  const int tid = otid(), lane = tid & 63;
  const int wu = __builtin_amdgcn_readfirstlane(tid >> 6);
  const int h = lane >> 5, l31 = lane & 31;
  LAS unsigned char* lds = (LAS unsigned char*)smem;
  float* bias_s = (float*)(smem + 2 * BUFB);
  if (vb >= 256) return;
  const int hk = (vb >> 7) & 1, cq = vb & 127;
  const int tile0 = cq >= 2 ? cq - 2 : 0, ntl = cq - tile0 + 1;
  const int npieces = ntl * 18;
  __syncthreads();
  {
    const float* bt = (const float*)(ws + OFF_BIAS);
    for (int i = tid; i < 2048; i += NTHR) bias_s[i] = bt[(hk * 8 + (i >> 8)) * 256 + (i & 255)];
  }
  const int nitem = (vb + 3 * 256 < 1024) ? 4 : ((1024 - vb + 255) >> 8);
  auto issue_item = [&](int b, int buf) {
    const char* kbase = (const char*)(ws + OFF_KN) + ((size_t)b * SEQ + (size_t)tile0 * 64) * 256 + hk * 128;
    const char* vbase = (const char*)(ws + OFF_VT) + ((size_t)(b * 2 + hk) * 64) * (SEQ * 2) + (size_t)tile0 * 128;
#pragma unroll
    for (int i = 0; i < 7; ++i) {
      int P = wu + 8 * i;
      if (P >= npieces) P = wu;
      const int tile = P / 18, r = P - tile * 18;
      const bool isv = r >= 9;
      const int p = isv ? r - 9 : r;
      const char* src = isv ? vbase + (size_t)tile * 128 + piece_off<9>(p, lane, SEQ * 2)
                            : kbase + (size_t)tile * (64 * 256) + piece_off<9>(p, lane, 256);
      glds16(src, lds + buf * BUFB + (isv ? 3 * TB : 0) + tile * TB + p * 1024);
    }
  };
  const int qoff = (64 * cq + 32 * (wu & 1) + l31) * 1024 + (hk * 8 + (wu >> 1)) * 64 + h * 8;
  const bf16_t* qp = (const bf16_t*)(ws + OFF_Q);
  bf16x8 qn[2][4];
  issue_item(0, 0);
#pragma unroll
  for (int s2 = 0; s2 < 2; ++s2)
#pragma unroll
    for (int ks = 0; ks < 4; ++ks) qn[s2][ks] = *(const bf16x8*)(qp + qoff + s2 * 256 + ks * 16);
  asm volatile("s_waitcnt vmcnt(0)" ::: "memory");
  __syncthreads();
  const int sig = (l31 & 0x13) | ((l31 & 4) << 1) | ((l31 & 8) >> 1);
  const int kofs = sig * 144 + h * 16;
  const int vofs = 3 * TB + l31 * 144 + h * 16;
  for (int b = 0; b < nitem; ++b) {
    const int buf = b & 1;
    bf16x8 qc[2][4];
#pragma unroll
    for (int s2 = 0; s2 < 2; ++s2)
#pragma unroll
      for (int ks = 0; ks < 4; ++ks) qc[s2][ks] = qn[s2][ks];
    if (b + 1 < nitem) {
      issue_item(b + 1, buf ^ 1);
#pragma unroll
      for (int s2 = 0; s2 < 2; ++s2)
#pragma unroll
        for (int ks = 0; ks < 4; ++ks) qn[s2][ks] = *(const bf16x8*)(qp + (size_t)(b + 1) * SEQ * 1024 + qoff + s2 * 256 + ks * 16);
    }
    __syncthreads();
    const char* Kb = smem + buf * BUFB;
#pragma unroll 1
    for (int s2 = 0; s2 < 2; ++s2) {
      const int g = s2 * 4 + (wu >> 1);
      const int hq = hk * 8 + g;
      const int row = b * SEQ + 64 * cq + 32 * (wu & 1) + l31;
      const bf16_t* sg = (const bf16_t*)(ws + OFF_SGATE) + (size_t)row * 1024 + hq * 64;
      u32x4 gv[2][2];
#pragma unroll
      for (int db = 0; db < 2; ++db)
#pragma unroll
        for (int k = 0; k < 2; ++k) gv[db][k] = *(const u32x4*)(sg + 32 * db + 16 * k + 8 * h);
      float m_run = sinks[(layer - 2) * 16 + hq] * LOG2E;
      float l_run = (h == 0) ? 1.f : 0.f;
      f32x16 o[2];
#pragma unroll
      for (int db = 0; db < 2; ++db)
#pragma unroll
        for (int r = 0; r < 16; ++r) o[db][r] = 0.f;
      for (int tj = 0; tj < ntl; ++tj) {
        const char* Ks = Kb + tj * TB;
        f32x16 c0, c1;
        {
          const float ninit = -m_run;
#pragma unroll
          for (int r = 0; r < 16; ++r) { c0[r] = ninit; c1[r] = ninit; }
        }
#pragma unroll
        for (int ks = 0; ks < 4; ++ks) {
          const bf16x8 a0 = *(const bf16x8*)(Ks + kofs + ks * 32);
          const bf16x8 a1 = *(const bf16x8*)(Ks + kofs + 32 * 144 + ks * 32);
          const bf16x8 qb = s2 == 0 ? qc[0][ks] : qc[1][ks];
          c0 = __builtin_amdgcn_mfma_f32_32x32x16_bf16(a0, qb, c0, 0, 0, 0);
          c1 = __builtin_amdgcn_mfma_f32_32x32x16_bf16(a1, qb, c1, 0, 0, 0);
        }
        {
          const int base = (tile0 + tj - cq) * 64 - 32 * (wu & 1) - l31 + 191 + 8 * h;
          const float* bs = bias_s + g * 256 + base;
#pragma unroll
          for (int r = 0; r < 16; ++r) {
            const int ko = 16 * (r >> 3) + 4 * ((r >> 2) & 1) + (r & 3);
            c0[r] += bs[ko];
            c1[r] += bs[32 + ko];
          }
        }
        float mx = c0[0];
#pragma unroll
        for (int r = 1; r < 16; ++r) mx = fmaxf(mx, c0[r]);
#pragma unroll
        for (int r = 0; r < 16; ++r) mx = fmaxf(mx, c1[r]);
        mx = swapmax(mx);
        if (!__all(mx <= THR)) {
          const float dlt = fmaxf(mx, 0.f);
          const float alpha = __builtin_amdgcn_exp2f(-dlt);
          m_run += dlt;
          l_run *= alpha;
#pragma unroll
          for (int db = 0; db < 2; ++db)
#pragma unroll
            for (int r = 0; r < 16; ++r) o[db][r] *= alpha;
#pragma unroll
          for (int r = 0; r < 16; ++r) { c0[r] -= dlt; c1[r] -= dlt; }
        }
        float ps = 0.f;
#pragma unroll
        for (int r = 0; r < 16; ++r) {
          c0[r] = __builtin_amdgcn_exp2f(c0[r]);
          c1[r] = __builtin_amdgcn_exp2f(c1[r]);
          ps += c0[r] + c1[r];
        }
        l_run += ps;
        bf16x8 pb[4];
        {
          u32x4 t0 = {cvtpk(c0[0], c0[1]), cvtpk(c0[2], c0[3]), cvtpk(c0[4], c0[5]), cvtpk(c0[6], c0[7])};
          u32x4 t1 = {cvtpk(c0[8], c0[9]), cvtpk(c0[10], c0[11]), cvtpk(c0[12], c0[13]), cvtpk(c0[14], c0[15])};
          u32x4 t2 = {cvtpk(c1[0], c1[1]), cvtpk(c1[2], c1[3]), cvtpk(c1[4], c1[5]), cvtpk(c1[6], c1[7])};
          u32x4 t3 = {cvtpk(c1[8], c1[9]), cvtpk(c1[10], c1[11]), cvtpk(c1[12], c1[13]), cvtpk(c1[14], c1[15])};
          pb[0] = *(bf16x8*)&t0; pb[1] = *(bf16x8*)&t1; pb[2] = *(bf16x8*)&t2; pb[3] = *(bf16x8*)&t3;
        }
        const char* Vs = Kb + tj * TB;
#pragma unroll
        for (int db = 0; db < 2; ++db)
#pragma unroll
          for (int t = 0; t < 4; ++t) {
            const bf16x8 va = *(const bf16x8*)(Vs + vofs + db * 32 * 144 + t * 32);
            o[db] = __builtin_amdgcn_mfma_f32_32x32x16_bf16(va, pb[t], o[db], 0, 0, 0);
          }
      }
      const float inv = 1.f / swapsum(l_run);
      bf16_t* og = (bf16_t*)(ws + OFF_OG) + (size_t)row * 1024 + hq * 64;
#pragma unroll
      for (int db = 0; db < 2; ++db)
#pragma unroll
        for (int k = 0; k < 2; ++k) {
          float ev[8];
#pragma unroll
          for (int j = 0; j < 4; ++j) {
            auto sw = __builtin_amdgcn_permlane32_swap(__float_as_uint(o[db][(2 * k) * 4 + j]), __float_as_uint(o[db][(2 * k + 1) * 4 + j]), false, false);
            ev[j] = __uint_as_float(sw[0]);
            ev[4 + j] = __uint_as_float(sw[1]);
          }
          const int d = 32 * db + 16 * k + 8 * h;
          const u32x4 g4 = gv[db][k];
          u32x4 ov;
#pragma unroll
          for (int i = 0; i < 4; ++i) {
            const float g0 = __uint_as_float(g4[i] << 16), g1 = __uint_as_float(g4[i] & 0xffff0000u);
            ov[i] = cvtpk(ev[2 * i] * inv * g0, ev[2 * i + 1] * inv * g1);
          }
          *(u32x4*)(og + d) = ov;
        }
    }
    asm volatile("s_waitcnt vmcnt(0)" ::: "memory");
    __syncthreads();
  }
}

#define XB_TMO      128
#define XB_XCNT(j)  (256  + 64 * (j))
#define XB_XSUB(j)  (1280 + 64 * (j))
#define XB_XGEN(j)  (2304 + 64 * (j))
#define XB_TOP      3328
#define XB_TOPGEN   3392
#define XCD_BAR_WORDS 3456
#define XB_SPIN_CAP (1u << 22)
DEV unsigned xb_ld(unsigned* p) { return __hip_atomic_load(p, __ATOMIC_RELAXED, __HIP_MEMORY_SCOPE_AGENT); }
DEV unsigned xb_add(unsigned* p, unsigned v) { return __hip_atomic_fetch_add(p, v, __ATOMIC_RELAXED, __HIP_MEMORY_SCOPE_AGENT); }
DEV unsigned xb_xcc_id() { return (unsigned)__builtin_amdgcn_s_getreg((3 << 11) | 20) & 0xFu; }
#define XB_SPIN(cond, bar) do { unsigned _sp = 0; while (cond) { __builtin_amdgcn_s_sleep(1); \
    if ((++_sp & 255u) == 0u) { if (xb_ld(&(bar)[XB_TMO])) break; if (_sp > XB_SPIN_CAP) { atomicAdd(&(bar)[XB_TMO], 1u); break; } } } } while (0)
struct XcdBarrier { unsigned* bar; unsigned x; volatile LAS unsigned* st; };
DEV XcdBarrier xcd_barrier_post(unsigned* bar, volatile LAS unsigned* st) {
  XcdBarrier b; b.bar = bar; b.x = xb_xcc_id(); b.st = st;
  if (threadIdx.x == 0) (void)xb_add(&bar[XB_XCNT(b.x)], 1u);
  return b;
}
DEV void xcd_barrier_complete(unsigned* bar, unsigned x, unsigned& nloc, unsigned& nx) {
  const unsigned G = gridDim.x * gridDim.y * gridDim.z;
  unsigned sum, cnt, mine, sp = 0u;
  for (;;) {
    sum = 0u; cnt = 0u; mine = 0u;
#pragma unroll
    for (unsigned j = 0; j < 16; ++j) { const unsigned c = xb_ld(&bar[XB_XCNT(j)]); sum += c; cnt += (c > 0u) ? 1u : 0u; mine = (j == x) ? c : mine; }
    if (sum == G) break;
    __builtin_amdgcn_s_sleep(1);
    if ((++sp & 255u) == 0u) { if (xb_ld(&bar[XB_TMO])) break; if (sp > XB_SPIN_CAP) { atomicAdd(&bar[XB_TMO], 1u); break; } }
  }
  nloc = mine > 0u ? mine : 1u; nx = cnt > 0u ? cnt : 1u;
}
DEV void xcd_barrier(const XcdBarrier& b) {
  asm volatile("s_waitcnt vmcnt(0)" ::: "memory");
  __syncthreads();
  if (threadIdx.x == 0) {
    unsigned* bar = b.bar;
    __builtin_amdgcn_s_waitcnt(0);
    unsigned nloc = b.st[0], nx = b.st[1];
    if (nloc == 0u) { xcd_barrier_complete(bar, b.x, nloc, nx); b.st[0] = nloc; b.st[1] = nx; }
    const unsigned old = xb_add(&bar[XB_XSUB(b.x)], 1u);
    const unsigned gen = old / nloc;
    if (old + 1u == (gen + 1u) * nloc) {
      __builtin_amdgcn_fence(__ATOMIC_RELEASE, "agent");
      asm volatile("s_waitcnt vmcnt(0)" ::: "memory");
      const unsigned og = xb_add(&bar[XB_TOP], 1u);
      const unsigned tg = og / nx;
      if (og + 1u == (tg + 1u) * nx) xb_add(&bar[XB_TOPGEN], 1u);
      else XB_SPIN(xb_ld(&bar[XB_TOPGEN]) == tg, bar);
      __builtin_amdgcn_fence(__ATOMIC_ACQUIRE, "agent");
      xb_add(&bar[XB_XGEN(b.x)], 1u);
      asm volatile("s_waitcnt vmcnt(0)" ::: "memory");
    } else {
      XB_SPIN(xb_ld(&bar[XB_XGEN(b.x)]) == gen, bar);
      __builtin_amdgcn_fence(__ATOMIC_ACQUIRE, "agent");
      asm volatile("s_waitcnt vmcnt(0)" ::: "memory");
    }
  }
  __syncthreads();
}

constexpr int N_PHASES = 1 + 2 * 4 + 2 * 3 + 1;

__global__ void __launch_bounds__(512, 2) yoco_megakernel(Params p) {
  extern __shared__ __attribute__((aligned(16))) char smem[];
  cg::grid_group grid = cg::this_grid();
  const int nb = gridDim.x;
  const int vb = ((nb & 7) == 0) ? (int)((blockIdx.x & 7) * (nb >> 3) + (blockIdx.x >> 3)) : (int)blockIdx.x;
  __shared__ int s_item;
  __shared__ uint4 xb_words;
  if (threadIdx.x == 0) xb_words = make_uint4(0u, 0u, 0u, 0u);
  __syncthreads();
  const XcdBarrier xb = xcd_barrier_post((unsigned*)(p.ws + OFF_BAR), (volatile LAS unsigned*)&xb_words);

  int ph0 = p.phase_lo;
  bool need_sync = false;
  if (ph0 == 0) {
    phase0(p, vb, nb, smem);
#if PROBE == 5
    __syncthreads();
    phase0(p, vb, nb, smem);
#endif
    ph0 = 1;
    if (p.phase_hi < 0) grid.sync();
    need_sync = true;
  }
  for (int ph = ph0; ph < p.phase_hi; ++ph) {
    if (need_sync) xcd_barrier(xb);
    need_sync = true;
    int layer, sub;
    if (ph <= 8) { layer = (ph - 1) >> 2; sub = (ph - 1) & 3; }
    else if (ph <= 14) { layer = 2 + (ph - 9) / 3; sub = (ph - 9) % 3; if (sub > 0) sub += 1; }
    else { layer = 3; sub = 4; }
    char* ws = p.ws;
    float* outp = p.out;
    asm volatile("" : "+s"(ws), "+s"(outp), "+s"(layer));
    if (sub == 4) {
      ln_phase(ws, outp, p.in[12], p.in[13], layer, vb, nb);
    } else if (layer < 2) {
      if (sub == 0) {
        if (layer == 0) fold_reduce(ws, vb, nb);
        for (int t = vb; t < 128 * 7; t += nb) {
          if (layer == 1) ln_stats(ws, 0, (t / 7) * 256, smem);
          p1_tile(ws, layer, t, smem);
        }
      } else if (sub == 1) {
        const int total = 128 * 14;
        const int per = (total + nb - 1) / nb;
        int lo = vb * per, hi = lo + per;
        if (hi > total) hi = total;
        int cur_mt = -1;
        for (int t = lo; t < hi; ++t) {
          const int mt = t / 14, nt = t % 14;
          if (mt != cur_mt) { p2_rowscale(ws, mt * 256, smem); cur_mt = mt; }
          p2_tile(ws, layer, mt, nt, smem);
        }
      } else if (sub == 2) {
        int* cnt = (int*)(ws + OFF_CNT) + layer * 8;
        const int xq0 = (int)(xb_xcc_id() & 7u);
        for (int qi = 0; qi < 8; ++qi) {
          const int xq = (xq0 + qi) & 7;
          for (;;) {
            __syncthreads();
            if (threadIdx.x == 0) s_item = atomicAdd(cnt + xq, 1);
            __syncthreads();
            const int e = s_item;
            if (e >= 128) break;
            const int pair = xq * 4 + (e >> 5);
            const int item = (pair << 5) | (31 - (e & 31));
            attn_item<true>(ws, p.in[9], layer, item, smem);
          }
        }
      } else {
        for (int t = vb; t < 128 * 4; t += nb) pout_tile(ws, outp, p.in[0], p.in[12], p.in[13], layer, t, smem);
      }
    } else {
      if (sub == 0) {
        const bf16_t* Bt = (const bf16_t*)(ws + (layer == 2 ? OFF_WT_IN_B0 : OFF_WT_IN_B1));
        const int cbase = (layer == 2) ? 1792 : 4096;
        for (int t = vb; t < 128 * 8; t += nb) {
          ln_stats(ws, layer - 1, (t >> 3) * 256, smem);
          p5_tile<false>(ws, (t >> 3) * 256, (t & 7) * 256, Bt, cbase, smem);
        }
        if (layer == 2)
          for (int t = vb; t < 128; t += nb) {
            ln_stats(ws, layer - 1, t * 256, smem);
            p5_tile<true>(ws, t * 256, 2048, Bt, cbase, smem);
          }
      } else if (sub == 2) {
        if (nb == 256) swa_phase(ws, p.in[9], layer, vb, nb, smem);
        else for (int t = vb; t < 2048; t += nb) attn_item<false>(ws, p.in[9], layer, t, smem);
      } else {
        for (int t = vb; t < 128 * 4; t += nb) pout_tile(ws, outp, p.in[0], p.in[12], p.in[13], layer, t, smem);
      }
    }
  }
}

extern "C" void kernel_launch(void* const* d_in, const int* in_sizes, int n_in, void* d_out, int out_size, void* d_ws,
                              size_t ws_size, hipStream_t stream) {
  (void)in_sizes; (void)n_in; (void)out_size;
  if (ws_size < WS_NEEDED) {
    fprintf(stderr, "workspace too small: %zu < %zu\n", ws_size, (size_t)WS_NEEDED);
    return;
  }
  Params p;
  memset(&p, 0, sizeof(p));
  for (int i = 0; i < 14; ++i) p.in[i] = (const float*)d_in[i];
  p.out = (float*)d_out;
  p.ws = (char*)d_ws;

  static int grid_blocks = 0;
  if (!grid_blocks) {
    int dev = 0, cus = 0, per_cu = 0;
    hipGetDevice(&dev);
    hipDeviceGetAttribute(&cus, hipDeviceAttributeMultiprocessorCount, dev);
    hipFuncSetAttribute((const void*)yoco_megakernel, hipFuncAttributeMaxDynamicSharedMemorySize, SMEM_BYTES);
    hipOccupancyMaxActiveBlocksPerMultiprocessor(&per_cu, yoco_megakernel, NTHR, SMEM_BYTES);
    if (per_cu > 1) per_cu = 1;
    if (per_cu < 1) per_cu = 1;
    grid_blocks = cus * per_cu;
  }
#ifdef MULTI_LAUNCH
  for (int ph = 0; ph < N_PHASES; ++ph) {
    p.phase_lo = ph; p.phase_hi = ph + 1;
    hipLaunchKernelGGL(yoco_megakernel, dim3(grid_blocks), dim3(NTHR), SMEM_BYTES, stream, p);
  }
#else
  p.phase_lo = 0; p.phase_hi = N_PHASES;
  (void)hipMemsetAsync((char*)d_ws + OFF_BAR, 0, 16384, stream);
  void* args[] = {&p};
  hipError_t e = hipLaunchCooperativeKernel((void*)yoco_megakernel, dim3(grid_blocks), dim3(NTHR), args, SMEM_BYTES, stream);
  if (e != hipSuccess) fprintf(stderr, "cooperative launch failed: %s (grid %d)\n", hipGetErrorString(e), grid_blocks);
#endif
}
```

```cpp
#ifndef PROBE
#define PROBE 0
#endif
#include <hip/hip_runtime.h>
#include <hip/hip_cooperative_groups.h>
#include <cstdio>
#include <cstring>
namespace cg = cooperative_groups;

typedef unsigned short bf16_t;
typedef __attribute__((ext_vector_type(8))) short bf16x8;
typedef __attribute__((ext_vector_type(16))) float f32x16;
typedef __attribute__((ext_vector_type(4))) float f32x4;
typedef __attribute__((ext_vector_type(4))) unsigned u32x4;
typedef __attribute__((ext_vector_type(2))) unsigned u32x2;

#define DEV __device__ __forceinline__
#define PHASE_FN __device__ __forceinline__

constexpr int T_TOK = 32768;
constexpr int SEQ = 8192;
constexpr int DM = 1024;
constexpr float LOG2E = 1.4426950408889634f;
constexpr float QSCALE_A = 0.07216878364870322f * LOG2E;
constexpr float QSCALE_B = 0.125f * LOG2E;
constexpr float DN_ALPHA = 1.681792830507429f;
constexpr float EPS = 1e-5f;
constexpr int NTHR = 512;
constexpr int NWAVE = 8;

constexpr size_t SZ_WT_IN_A = (size_t)1792 * 1024 * 2;
constexpr size_t SZ_WT_UQ = (size_t)1536 * 384 * 2;
constexpr size_t SZ_WT_UKV = (size_t)2048 * 256 * 2;
constexpr size_t SZ_WT_O = (size_t)1024 * 1024 * 2;
constexpr size_t SZ_WT_IN_B0 = (size_t)2304 * 1024 * 2;
constexpr size_t SZ_WT_IN_B1 = (size_t)2048 * 1024 * 2;
constexpr size_t OFF_WT_IN_A = 0;
constexpr size_t OFF_WT_UQ = OFF_WT_IN_A + 2 * SZ_WT_IN_A;
constexpr size_t OFF_WT_UKV = OFF_WT_UQ + 2 * SZ_WT_UQ;
constexpr size_t OFF_WT_O_A = OFF_WT_UKV + 2 * SZ_WT_UKV;
constexpr size_t OFF_WT_IN_B0 = OFF_WT_O_A + 2 * SZ_WT_O;
constexpr size_t OFF_WT_IN_B1 = OFF_WT_IN_B0 + SZ_WT_IN_B0;
constexpr size_t OFF_WT_O_B = OFF_WT_IN_B1 + SZ_WT_IN_B1;
constexpr size_t OFF_COS = OFF_WT_O_B + 2 * SZ_WT_O;
constexpr size_t OFF_SIN = OFF_COS + (size_t)SEQ * 32 * 4;
constexpr size_t OFF_BIAS = OFF_SIN + (size_t)SEQ * 32 * 4;
constexpr size_t OFF_CNT = OFF_BIAS + 16 * 256 * 4;
constexpr size_t OFF_BAR = OFF_CNT + 4096;
constexpr size_t OFF_PART = OFF_BAR + 16384;
constexpr size_t OFF_CSBW = OFF_PART + 2 * 16 * 6144 * 4;
constexpr size_t OFF_PSUM = OFF_CSBW + 2 * 6144 * 4;
constexpr size_t OFF_STATS = OFF_PSUM + (size_t)T_TOK * 8 * 4;
constexpr size_t OFF_XB = OFF_STATS + (size_t)3 * T_TOK * 2 * 4;
constexpr size_t OFF_CQKV = OFF_XB + (size_t)T_TOK * 1024 * 2;
constexpr size_t OFF_KROPE = OFF_CQKV + (size_t)T_TOK * 640 * 2;
constexpr size_t OFF_SGATE = OFF_KROPE + (size_t)T_TOK * 64 * 2;
constexpr size_t OFF_Q = OFF_SGATE + (size_t)T_TOK * 1024 * 2;
constexpr size_t OFF_KN = OFF_Q + (size_t)T_TOK * 1536 * 2;
constexpr size_t OFF_VT = OFF_KN + (size_t)T_TOK * 1024 * 2;
constexpr size_t OFF_OG = OFF_VT + (size_t)T_TOK * 1024 * 2;
constexpr size_t WS_NEEDED = OFF_OG + (size_t)T_TOK * 1024 * 2;

struct Params {
  const float* in[14];
  float* out;
  char* ws;
  int phase_lo, phase_hi;
};

DEV unsigned cvtpk(float lo, float hi) {
  unsigned r;
  asm("v_cvt_pk_bf16_f32 %0, %1, %2" : "=v"(r) : "v"(lo), "v"(hi));
  return r;
}
DEV bf16_t f2bf(float v) { return (bf16_t)(cvtpk(v, v) & 0xffffu); }
DEV float bf2f(bf16_t v) { return __uint_as_float(((unsigned)v) << 16); }
DEV float swapmax(float v) {
  auto rr = __builtin_amdgcn_permlane32_swap(__float_as_uint(v), __float_as_uint(v), false, false);
  return fmaxf(__uint_as_float(rr[0]), __uint_as_float(rr[1]));
}
DEV float swapsum(float v) {
  auto rr = __builtin_amdgcn_permlane32_swap(__float_as_uint(v), __float_as_uint(v), false, false);
  return __uint_as_float(rr[0]) + __uint_as_float(rr[1]);
}
DEV int otid() { int t = threadIdx.x; asm volatile("" : "+v"(t)); return t; }
DEV float silu(float v) { return v * __builtin_amdgcn_rcpf(1.f + __builtin_amdgcn_exp2f(-1.4426950408889634f * v)); }
DEV float wave_sum(float v) {
#pragma unroll
  for (int o = 32; o >= 1; o >>= 1) v += __shfl_xor(v, o);
  return v;
}

#define LAS __attribute__((address_space(3)))
constexpr int HTB = 128 * 64 * 2;
constexpr int GEMM_LDS = 8 * HTB;
constexpr int SMEM_BYTES = 3 * (26624 + 18432) + 1024;
#define SA_(b, h) (((b) * 2 + (h)) * HTB)
#define SB_(b, h) ((4 + (b) * 2 + (h)) * HTB)

DEV int lds_byte(int r, int c) {
  int st = (r >> 4) * 2 + (c >> 5), rr = r & 15, cc = c & 31, ob = rr * 64 + cc * 2;
  return st * 1024 + (ob ^ (((ob >> 9) & 1) << 5));
}
DEV void stage_rc(int b, int& R, int& C) {
  int st = b >> 10, sb = b & 1023, swz = sb ^ (((sb >> 9) & 1) << 5);
  R = (st >> 1) * 16 + (swz >> 6);
  C = (st & 1) * 32 + ((swz & 63) >> 1);
}

template <bool SWAP>
DEV void mma_blk(f32x4 (&acc)[4][2], const bf16x8 (&At)[4][2], const bf16x8 (&Bf)[2][2]) {
  __builtin_amdgcn_s_setprio(3);
#pragma unroll
  for (int m = 0; m < 4; ++m)
#pragma unroll
    for (int n = 0; n < 2; ++n)
#pragma unroll
      for (int k = 0; k < 2; ++k) {
        if (SWAP) acc[m][n] = __builtin_amdgcn_mfma_f32_16x16x32_bf16(Bf[n][k], At[m][k], acc[m][n], 0, 0, 0);
        else acc[m][n] = __builtin_amdgcn_mfma_f32_16x16x32_bf16(At[m][k], Bf[n][k], acc[m][n], 0, 0, 0);
      }
  __builtin_amdgcn_s_setprio(0);
}

template <bool VT1>
DEV void gemm256(const bf16_t* __restrict__ A, int lda, const bf16_t* __restrict__ Bt, int ldb, int K, int brow, int bcol,
                 LAS unsigned char* lds, f32x4 (&acc)[2][2][4][2]) {
  const int tid = otid();
  const int wid = __builtin_amdgcn_readfirstlane(tid >> 6), lane = tid & 63, wr = wid >> 2, wc = wid & 3, fr = lane & 15, fq = lane >> 4;
  const int nt = K >> 6;
  unsigned voffA[2], voffB[2];
#pragma unroll
  for (int i = 0; i < 2; ++i) {
    int R, C;
    stage_rc(tid * 16 + i * 8192, R, C);
    voffA[i] = (unsigned)(R * lda + C) * 2u;
    voffB[i] = (unsigned)(R * ldb + C) * 2u;
  }
  const size_t hA = (size_t)128 * lda * 2, hB = (size_t)128 * ldb * 2;
  const unsigned ldsw = (unsigned)wid * 1024u;
  const int aoff = lds_byte(wr * 64 + fr, fq * 8), boff = lds_byte(wc * 32 + fr, fq * 8);
  const char* cA = (const char*)A + (size_t)brow * lda * 2;
  const char* cB = (const char*)Bt + (size_t)bcol * ldb * 2;
#pragma unroll
  for (int a = 0; a < 2; ++a)
#pragma unroll
    for (int b = 0; b < 2; ++b)
#pragma unroll
      for (int m = 0; m < 4; ++m)
#pragma unroll
        for (int n = 0; n < 2; ++n) acc[a][b][m][n] = (f32x4){0.f, 0.f, 0.f, 0.f};
  bf16x8 At[4][2], B0[2][2], B1[2][2];
#define STAGE(bufoff, gbase, voff)                                                                                       \
  do {                                                                                                                   \
    _Pragma("unroll") for (int _i = 0; _i < 2; ++_i) __builtin_amdgcn_global_load_lds(                                   \
        (const unsigned*)((const char*)(gbase) + (voff)[_i]), (LAS unsigned*)(lds + (bufoff) + ldsw + _i * 8192), 16, 0, 0); \
  } while (0)
#define LDA(dst, b, h)                                                                                                   \
  do {                                                                                                                   \
    _Pragma("unroll") for (int m = 0; m < 4; ++m) _Pragma("unroll") for (int k = 0; k < 2; ++k) dst[m][k] =              \
        *(const LAS bf16x8*)(lds + SA_(b, h) + aoff + m * 2048 + k * 1024);                                              \
  } while (0)
#define LDB(dst, b, h)                                                                                                   \
  do {                                                                                                                   \
    _Pragma("unroll") for (int n = 0; n < 2; ++n) _Pragma("unroll") for (int k = 0; k < 2; ++k) dst[n][k] =              \
        *(const LAS bf16x8*)(lds + SB_(b, h) + boff + n * 2048 + k * 1024);                                              \
  } while (0)
#define MMA0(ai, Bf) mma_blk<true>(acc[ai][0], At, Bf)
#define MMA1(ai, Bf) mma_blk<!VT1>(acc[ai][1], At, Bf)
#define WAIT_V(n) asm volatile("s_waitcnt vmcnt(" #n ")" ::: "memory")
#define WAIT_L(n) asm volatile("s_waitcnt lgkmcnt(" #n ")" ::: "memory")
#define BAR __builtin_amdgcn_s_barrier()
#define SCHED __builtin_amdgcn_sched_barrier(0)
#define KT(p, t) ((p) + (size_t)(t) * 128)
  STAGE(SB_(0, 0), cB, voffB); STAGE(SA_(0, 0), cA, voffA); STAGE(SB_(0, 1), cB + hB, voffB); STAGE(SA_(0, 1), cA + hA, voffA);
  if (wr == 1) BAR;
  WAIT_V(4); BAR;
  STAGE(SB_(1, 0), KT(cB, 1), voffB); STAGE(SA_(1, 0), KT(cA, 1), voffA); STAGE(SB_(1, 1), KT(cB + hB, 1), voffB);
  WAIT_V(6); BAR;
  for (int t = 0; t < nt - 2; t += 2) {
    LDB(B0, 0, 0); SCHED; LDA(At, 0, 0); STAGE(SA_(1, 1), KT(cA + hA, t + 1), voffA);
    WAIT_L(8); BAR; WAIT_L(0); MMA0(0, B0); BAR; SCHED;
    LDB(B1, 0, 1); STAGE(SB_(0, 0), KT(cB, t + 2), voffB);
    BAR; WAIT_L(0); MMA1(0, B1); BAR;
    LDA(At, 0, 1); STAGE(SA_(0, 0), KT(cA, t + 2), voffA);
    BAR; WAIT_L(0); MMA0(1, B0); BAR; SCHED;
    STAGE(SB_(0, 1), KT(cB + hB, t + 2), voffB);
    WAIT_V(6); BAR; MMA1(1, B1); BAR;
    LDB(B0, 1, 0); SCHED; LDA(At, 1, 0); STAGE(SA_(0, 1), KT(cA + hA, t + 2), voffA);
    WAIT_L(8); BAR; WAIT_L(0); MMA0(0, B0); BAR; SCHED;
    LDB(B1, 1, 1); STAGE(SB_(1, 0), KT(cB, t + 3), voffB);
    BAR; WAIT_L(0); MMA1(0, B1); BAR;
    LDA(At, 1, 1); STAGE(SA_(1, 0), KT(cA, t + 3), voffA);
    BAR; WAIT_L(0); MMA0(1, B0); BAR; SCHED;
    STAGE(SB_(1, 1), KT(cB + hB, t + 3), voffB);
    WAIT_V(6); BAR; MMA1(1, B1); BAR;
  }
  {
    LDB(B0, 0, 0); LDA(At, 0, 0); STAGE(SA_(1, 1), KT(cA + hA, nt - 1), voffA);
    BAR; WAIT_L(0); MMA0(0, B0); BAR;
    LDB(B1, 0, 1); BAR; WAIT_L(0); MMA1(0, B1); BAR;
    LDA(At, 0, 1); WAIT_V(4); BAR; WAIT_L(0); MMA0(1, B0); MMA1(1, B1); BAR;
  }
  {
    LDB(B0, 1, 0); LDA(At, 1, 0); WAIT_V(2); BAR; WAIT_L(0); MMA0(0, B0); BAR;
    LDB(B1, 1, 1); WAIT_V(0); BAR; WAIT_L(0); MMA1(0, B1); BAR;
    LDA(At, 1, 1); BAR; WAIT_L(0); MMA0(1, B0); MMA1(1, B1); BAR;
  }
  if (wr == 0) BAR;
#undef STAGE
#undef LDA
#undef LDB
#undef MMA0
#undef MMA1
#undef KT
}

struct EpiIdx { int wr, wc, fr, fq; };
DEV EpiIdx epi_idx() {
  const int tid = otid();
  const int wid = tid >> 6, lane = tid & 63;
  return EpiIdx{wid >> 2, wid & 3, lane & 15, lane >> 4};
}
DEV u32x2 pack4(float a, float b, float c, float d) { return u32x2{cvtpk(a, b), cvtpk(c, d)}; }
DEV u32x4 gather8(u32x2 a, u32x2 b) {
  u32x4 r;
#pragma unroll
  for (int d = 0; d < 2; ++d) {
    auto s1 = __builtin_amdgcn_permlane32_swap(a[d], b[d], false, false);
    auto s2 = __builtin_amdgcn_permlane16_swap(s1[0], s1[1], false, false);
    r[d] = s2[0];
    r[2 + d] = s2[1];
  }
  return r;
}

DEV void conv_tile(const float* __restrict__ src, const float* __restrict__ gain, bf16_t* __restrict__ dst, int K, int N, int ntn, int rope_mode,
                   int lt, char* smem) {
  const int k0 = (lt / ntn) * 64, n0 = (lt % ntn) * 64;
  float* tl = (float*)smem;
  const int tid = otid();
  __syncthreads();
  if (n0 < N) {
#pragma unroll
    for (int i = 0; i < 2; ++i) {
      const int k = (tid >> 4) + 32 * i, n = (tid & 15) * 4;
      f32x4 v = *(const f32x4*)(src + (size_t)(k0 + k) * N + n0 + n);
      const float g = gain ? gain[k0 + k] : 1.f;
      tl[k * 65 + n + 0] = v[0] * g;
      tl[k * 65 + n + 1] = v[1] * g;
      tl[k * 65 + n + 2] = v[2] * g;
      tl[k * 65 + n + 3] = v[3] * g;
    }
  }
  __syncthreads();
  const int n = tid >> 3, kc = (tid & 7) * 8;
  const bool rope = (rope_mode == 1 && n0 == 640) || (rope_mode == 2 && (n0 % 192) == 128);
  const int nn = rope ? ((n & 1) * 32 + (n >> 1)) : n;
  u32x4 o0;
  if (n0 < N) {
    float v[8];
#pragma unroll
    for (int q = 0; q < 8; ++q) v[q] = tl[(kc + q) * 65 + nn];
    o0 = u32x4{cvtpk(v[0], v[1]), cvtpk(v[2], v[3]), cvtpk(v[4], v[5]), cvtpk(v[6], v[7])};
  } else {
    o0 = u32x4{0, 0, 0, 0};
  }
  *(u32x4*)(dst + (size_t)(n0 + n) * K + k0 + kc) = o0;
}

DEV int t5_bucket(int rel) {
  const int ret = rel > 0 ? 16 : 0;
  const int n = rel < 0 ? -rel : rel;
  int large = 8 + (n >= 12) + (n >= 16) + (n >= 23) + (n >= 32) + (n >= 46) + (n >= 64) + (n >= 91);
  return ret + (n < 8 ? n : large);
}

DEV void sincos_d(float angf, float& sn, float& cs) {
  const double a = (double)angf;
  const double n = rint(a * 0.63661977236758134308);
  const double r = (a - n * 1.57079632679489655800) - n * 6.12323399573676603587e-17;
  const double r2 = r * r;
  double sp = -1.0 / 6227020800.0;
  sp = sp * r2 + 1.0 / 39916800.0;
  sp = sp * r2 - 1.0 / 362880.0;
  sp = sp * r2 + 1.0 / 5040.0;
  sp = sp * r2 - 1.0 / 120.0;
  sp = sp * r2 + 1.0 / 6.0;
  const double sr = r - r * r2 * sp;
  double cp = 1.0 / 87178291200.0;
  cp = cp * r2 - 1.0 / 479001600.0;
  cp = cp * r2 + 1.0 / 3628800.0;
  cp = cp * r2 - 1.0 / 40320.0;
  cp = cp * r2 + 1.0 / 720.0;
  cp = cp * r2 - 1.0 / 24.0;
  cp = cp * r2 + 0.5;
  const double cr = 1.0 - r2 * cp;
  const int q = ((int)n) & 3;
  const double s_ = (q & 1) ? cr : sr, c_ = (q & 1) ? sr : cr;
  sn = (float)((q & 2) ? -s_ : s_);
  cs = (float)(((q + 1) & 2) ? -c_ : c_);
}

DEV void phase0(const Params& p, int vb, int nb, char* smem) {
  const int tid = otid();
#define CONV_JOB(SRC, GAIN, DSTOFF, KK, NN, NPAD, RM)                                                        \
  {                                                                                                          \
    const float* jsrc = (SRC);                                                                               \
    const float* jgain = (GAIN);                                                                             \
    bf16_t* jdst = (bf16_t*)(p.ws + (DSTOFF));                                                               \
    constexpr int jntn = (NPAD) / 64;                                                                        \
    constexpr int jnt = ((KK) / 64) * jntn;                                                                  \
    for (int t = vb; t < jnt; t += nb) conv_tile(jsrc, jgain, jdst, (KK), (NN), jntn, (RM), t, smem);        \
  }
  for (int l = 0; l < 2; ++l) {
    CONV_JOB(p.in[1] + (size_t)l * 1024 * 1728, (l == 1 ? p.in[12] : (const float*)nullptr), OFF_WT_IN_A + l * SZ_WT_IN_A, 1024, 1728, 1792, 1)
    CONV_JOB(p.in[4] + (size_t)l * 384 * 1536, p.in[2] + l * 384, OFF_WT_UQ + l * SZ_WT_UQ, 384, 1536, 1536, 2)
    CONV_JOB(p.in[5] + (size_t)l * 256 * 2048, p.in[3] + l * 256, OFF_WT_UKV + l * SZ_WT_UKV, 256, 2048, 2048, 0)
    CONV_JOB(p.in[6] + (size_t)l * 1024 * 1024, nullptr, OFF_WT_O_A + l * SZ_WT_O, 1024, 1024, 1024, 0)
    CONV_JOB(p.in[10] + (size_t)l * 1024 * 1024, nullptr, OFF_WT_O_B + l * SZ_WT_O, 1024, 1024, 1024, 0)
  }
  CONV_JOB(p.in[8], p.in[12] + 1024, OFF_WT_IN_B0, 1024, 2048, 2048, 0)
  CONV_JOB(p.in[7], p.in[12] + 1024, OFF_WT_IN_B0 + (size_t)2048 * 1024 * 2, 1024, 256, 256, 0)
  CONV_JOB(p.in[8] + (size_t)1024 * 2048, p.in[12] + 2048, OFF_WT_IN_B1, 1024, 2048, 2048, 0)
#undef CONV_JOB
  {
    float* pcs = (float*)(p.ws + OFF_PART);
    float* pbw = pcs + 16 * 6144;
    for (int it = vb * NTHR + tid; it < 16 * 6144; it += nb * NTHR) {
      const int kc = it / 6144, n = it - kc * 6144;
      const float* W; int ldw, col, ln; bool valid = true;
      if (n < 1792) {
        W = p.in[1] + (size_t)1024 * 1728; ldw = 1728; ln = 0; col = n;
        if (n >= 640 && n < 704) { const int q = n - 640; col = 640 + (q & 1) * 32 + (q >> 1); }
        valid = n < 1728;
      } else if (n < 4096) {
        const int c = n - 1792; ln = 1;
        if (c < 2048) { W = p.in[8]; ldw = 2048; col = c; } else { W = p.in[7]; ldw = 256; col = c - 2048; }
      } else {
        W = p.in[8] + (size_t)1024 * 2048; ldw = 2048; ln = 2; col = n - 4096;
      }
      float scs = 0.f, sbw = 0.f;
      if (valid) {
        const float* g = p.in[12] + ln * 1024 + kc * 64;
        const float* bb = p.in[13] + ln * 1024 + kc * 64;
        const float* wp = W + (size_t)(kc * 64) * ldw + col;
#pragma unroll 8
        for (int k = 0; k < 64; ++k) {
          const float wv = wp[(size_t)k * ldw];
          scs += bf2f(f2bf(wv * g[k]));
          sbw += wv * bb[k];
        }
      }
      pcs[it] = scs;
      pbw[it] = sbw;
    }
  }
  {
    bf16_t* xb = (bf16_t*)(p.ws + OFF_XB);
    const size_t n8 = (size_t)T_TOK * DM / 8;
    for (size_t i = (size_t)vb * NTHR + tid; i < n8; i += (size_t)nb * NTHR) {
      f32x4 a = *(const f32x4*)(p.in[0] + i * 8);
      f32x4 b = *(const f32x4*)(p.in[0] + i * 8 + 4);
      *(u32x4*)(xb + i * 8) = u32x4{cvtpk(a[0], a[1]), cvtpk(a[2], a[3]), cvtpk(b[0], b[1]), cvtpk(b[2], b[3])};
    }
  }
  {
    float* ct = (float*)(p.ws + OFF_COS);
    float* st = (float*)(p.ws + OFF_SIN);
    for (int i = vb * NTHR + tid; i < SEQ * 32; i += nb * NTHR) {
      const int pos = i >> 5, j = i & 31;
      double invd = 1.0;
      for (int q = 0; q < j; ++q) invd *= 0.74989420933245582730;
      const float ang = (float)pos * (float)invd;
      float sn, cs;
      sincos_d(ang, sn, cs);
      ct[i] = cs;
      st[i] = sn;
    }
  }
  if (vb == 0) {
    float* bt = (float*)(p.ws + OFF_BIAS);
    for (int i = tid; i < 16 * 256; i += NTHR) {
      const int h = i >> 8, idx = i & 255;
      const int rel = idx - 191;
      bt[i] = p.in[11][t5_bucket(rel) * 16 + h] * LOG2E;
    }
    int* cnt = (int*)(p.ws + OFF_CNT);
    for (int i = tid; i < 1024; i += NTHR) cnt[i] = 0;
  }
}

DEV u32x2 rope4(const float* ct, const float* st, int pos, int jj, float v0, float v1, float v2, float v3) {
  const float2 cc = *(const float2*)(ct + pos * 32 + jj), ss = *(const float2*)(st + pos * 32 + jj);
  const float c0 = cc.x, s0 = ss.x, c1 = cc.y, s1 = ss.y;
  return pack4(v0 * c0 - v1 * s0, v1 * c0 + v0 * s0, v2 * c1 - v3 * s1, v3 * c1 + v2 * s1);
}

PHASE_FN void fold_reduce(char* ws, int vb, int nb) {
  const int tid = otid();
  const float* pcs = (const float*)(ws + OFF_PART);
  float* cs = (float*)(ws + OFF_CSBW);
  for (int n = vb * NTHR + tid; n < 2 * 6144; n += nb * NTHR) {
    const int a = n / 6144, c = n - a * 6144;
    float acc = 0.f;
#pragma unroll
    for (int kc = 0; kc < 16; ++kc) acc += pcs[(a * 16 + kc) * 6144 + c];
    cs[n] = acc;
  }
}

PHASE_FN void ln_stats(char* ws, int lprev, int m0, char* smem) {
  const int tid = otid();
  const int row = tid >> 1, half = tid & 1;
  const float* ps = (const float*)(ws + OFF_PSUM) + (size_t)(m0 + row) * 8 + half * 4;
  const f32x4 v = *(const f32x4*)ps;
  float sm = v[0] + v[2], sq = v[1] + v[3];
  sm += __shfl_xor(sm, 1);
  sq += __shfl_xor(sq, 1);
  const float mean = sm * (1.f / 1024.f);
  const float var = fmaxf(sq * (1.f / 1024.f) - mean * mean, 0.f);
  const float rstd = rsqrtf(var + EPS);
  float* rs = (float*)(smem + GEMM_LDS);
  __syncthreads();
  if (half == 0) {
    rs[row] = mean;
    rs[256 + row] = rstd;
    float* st = (float*)(ws + OFF_STATS) + ((size_t)lprev * T_TOK + m0 + row) * 2;
    st[0] = mean;
    st[1] = rstd;
  }
  __syncthreads();
}

PHASE_FN void p1_tile(char* ws, int layer, int tile, char* smem) {
  const int mt = tile / 7, nt = tile % 7;
  const int brow = mt * 256, bcol = nt * 256;
  const bf16_t* A = (const bf16_t*)(ws + OFF_XB);
  const bf16_t* Bt = (const bf16_t*)(ws + OFF_WT_IN_A + layer * SZ_WT_IN_A);
  f32x4 acc[2][2][4][2];
  gemm256<false>(A, 1024, Bt, 1024, 1024, brow, bcol, (LAS unsigned char*)smem, acc);
  const EpiIdx e = epi_idx();
  bf16_t* cq = (bf16_t*)(ws + OFF_CQKV);
  bf16_t* kr = (bf16_t*)(ws + OFF_KROPE);
  bf16_t* sg = (bf16_t*)(ws + OFF_SGATE);
  const float* ct = (const float*)(ws + OFF_COS);
  const float* st = (const float*)(ws + OFF_SIN);
#pragma unroll
  for (int bj = 0; bj < 2; ++bj) {
    const int cb = bcol + bj * 128 + e.wc * 32;
    if (cb >= 1728) continue;
    f32x4 c4h[2], b4h[2];
    if (layer == 1) {
#pragma unroll
      for (int n = 0; n < 2; ++n) {
        c4h[n] = *(const f32x4*)((const float*)(ws + OFF_CSBW) + cb + n * 16 + e.fq * 4);
        b4h[n] = *(const f32x4*)((const float*)(ws + OFF_CSBW) + 6144 + cb + n * 16 + e.fq * 4);
      }
    }
#pragma unroll
    for (int ai = 0; ai < 2; ++ai)
#pragma unroll
      for (int m = 0; m < 4; ++m)
        {
          const int rl = ai * 128 + e.wr * 64 + m * 16 + e.fr;
          const int row = brow + rl;
          u32x2 pk[2];
#pragma unroll
          for (int n = 0; n < 2; ++n) {
            const int col0 = cb + n * 16 + e.fq * 4;
            f32x4 v = acc[ai][bj][m][n];
            if (layer == 1) {
              const float* rs = (const float*)(smem + GEMM_LDS);
              const float mean = rs[rl], rstd = rs[256 + rl];
#pragma unroll
              for (int q = 0; q < 4; ++q) v[q] = rstd * (v[q] - mean * c4h[n][q]) + b4h[n][q];
            }
            if (cb < 640) pk[n] = pack4(v[0], v[1], v[2], v[3]);
            else if (cb < 704) pk[n] = rope4(ct, st, row & (SEQ - 1), (col0 - 640) >> 1, v[0], v[1], v[2], v[3]);
            else pk[n] = pack4(silu(v[0]), silu(v[1]), silu(v[2]), silu(v[3]));
          }
          const u32x4 w8 = gather8(pk[0], pk[1]);
          const int c8 = cb + e.fq * 8;
          if (cb < 640) *(u32x4*)(cq + (size_t)row * 640 + c8) = w8;
          else if (cb < 704) *(u32x4*)(kr + (size_t)row * 64 + (c8 - 640)) = w8;
          else *(u32x4*)(sg + (size_t)row * 1024 + (c8 - 704)) = w8;
        }
  }
}

PHASE_FN void p2_rowscale(char* ws, int m0, char* smem) {
  const int tid = otid();
  const int row = tid >> 1, half = tid & 1;
  const bf16_t* c = (const bf16_t*)(ws + OFF_CQKV) + (size_t)(m0 + row) * 640;
  float sq = 0.f, sk = 0.f;
#pragma unroll 4
  for (int i = 0; i < 24; ++i) {
    u32x4 v = *(const u32x4*)(c + half * 192 + i * 8);
#pragma unroll
    for (int e = 0; e < 4; ++e) {
      float a = __uint_as_float(v[e] << 16), b = __uint_as_float(v[e] & 0xffff0000u);
      sq += a * a + b * b;
    }
  }
#pragma unroll 4
  for (int i = 0; i < 16; ++i) {
    u32x4 v = *(const u32x4*)(c + 384 + half * 128 + i * 8);
#pragma unroll
    for (int e = 0; e < 4; ++e) {
      float a = __uint_as_float(v[e] << 16), b = __uint_as_float(v[e] & 0xffff0000u);
      sk += a * a + b * b;
    }
  }
  sq += __shfl_xor(sq, 1);
  sk += __shfl_xor(sk, 1);
  float* rs = (float*)(smem + GEMM_LDS);
  __syncthreads();
  if (half == 0) {
    rs[row] = rsqrtf(sq * (1.f / 384.f) + EPS);
    rs[256 + row] = rsqrtf(sk * (1.f / 256.f) + EPS);
  }
  __syncthreads();
}

PHASE_FN void p2_tile(char* ws, int layer, int mt, int nt, char* smem) {
  const int brow = mt * 256;
  const float* rs = (const float*)(smem + GEMM_LDS);
  const bf16_t* A = (const bf16_t*)(ws + OFF_CQKV);
  f32x4 acc[2][2][4][2];
  if (nt < 6) {
    const int bcol = nt * 256;
    const bf16_t* Bt = (const bf16_t*)(ws + OFF_WT_UQ + layer * SZ_WT_UQ);
    gemm256<false>(A, 640, Bt, 384, 384, brow, bcol, (LAS unsigned char*)smem, acc);
    const EpiIdx e = epi_idx();
    bf16_t* q = (bf16_t*)(ws + OFF_Q);
    const float* ct = (const float*)(ws + OFF_COS);
    const float* st = (const float*)(ws + OFF_SIN);
#pragma unroll
    for (int bj = 0; bj < 2; ++bj) {
      const int cb = bcol + bj * 128 + e.wc * 32;
      const int hc = cb % 192;
      const bool is_rope = hc >= 128;
#pragma unroll
      for (int ai = 0; ai < 2; ++ai)
#pragma unroll
        for (int m = 0; m < 4; ++m) {
          const int rl = ai * 128 + e.wr * 64 + m * 16 + e.fr;
          const int row = brow + rl;
          const float sc = rs[rl] * QSCALE_A;
          u32x2 pk[2];
#pragma unroll
          for (int n = 0; n < 2; ++n) {
            const f32x4 v = acc[ai][bj][m][n];
            if (is_rope) pk[n] = rope4(ct, st, row & (SEQ - 1), (hc - 128 + n * 16 + e.fq * 4) >> 1, v[0] * sc, v[1] * sc, v[2] * sc, v[3] * sc);
            else pk[n] = pack4(v[0] * sc, v[1] * sc, v[2] * sc, v[3] * sc);
          }
          *(u32x4*)(q + (size_t)row * 1536 + cb + e.fq * 8) = gather8(pk[0], pk[1]);
        }
    }
  } else {
    const int head = nt - 6;
    const int bcol = head * 256;
    const bf16_t* Bt = (const bf16_t*)(ws + OFF_WT_UKV + layer * SZ_WT_UKV);
    gemm256<true>(A + 384, 640, Bt, 256, 256, brow, bcol, (LAS unsigned char*)smem, acc);
    const EpiIdx e = epi_idx();
    bf16_t* kn = (bf16_t*)(ws + OFF_KN);
    bf16_t* vt = (bf16_t*)(ws + OFF_VT);
    const int b = brow >> 13;
#pragma unroll
    for (int ai = 0; ai < 2; ++ai)
#pragma unroll
      for (int m = 0; m < 4; ++m) {
        {
          const int rl = ai * 128 + e.wr * 64 + m * 16 + e.fr;
          const float sc = rs[256 + rl];
          u32x2 pk[2];
#pragma unroll
          for (int n = 0; n < 2; ++n) {
            const f32x4 v = acc[ai][0][m][n];
            pk[n] = pack4(v[0] * sc, v[1] * sc, v[2] * sc, v[3] * sc);
          }
          *(u32x4*)(kn + (size_t)(brow + rl) * 1024 + head * 128 + e.wc * 32 + e.fq * 8) = gather8(pk[0], pk[1]);
        }
        if ((m & 1) == 0) {
          const int rl0 = ai * 128 + e.wr * 64 + m * 16 + e.fq * 4;
          const f32x4 sc0 = *(const f32x4*)(rs + 256 + rl0), sc1 = *(const f32x4*)(rs + 256 + rl0 + 16);
          const int s8 = (brow + ai * 128 + e.wr * 64 + m * 16 + e.fq * 8) & (SEQ - 1);
#pragma unroll
          for (int n = 0; n < 2; ++n) {
            const f32x4 v0 = acc[ai][1][m][n], v1 = acc[ai][1][m + 1][n];
            const int d = e.wc * 32 + n * 16 + e.fr;
            *(u32x4*)(vt + ((size_t)((b * 8 + head) * 128 + d)) * SEQ + s8) =
                gather8(pack4(v0[0] * sc0[0], v0[1] * sc0[1], v0[2] * sc0[2], v0[3] * sc0[3]),
                        pack4(v1[0] * sc1[0], v1[1] * sc1[1], v1[2] * sc1[2], v1[3] * sc1[3]));
          }
        }
      }
  }
}

PHASE_FN void pout_tile(char* ws, float* out, const float* x, const float* ln_gain, const float* ln_bias, int layer, int tile, char* smem) {
  const int mt = tile >> 2, nt = tile & 3;
  const int brow = mt * 256, bcol = nt * 256;
  const bf16_t* A = (const bf16_t*)(ws + OFF_OG);
  const bf16_t* Bt = (const bf16_t*)(ws + (layer < 2 ? OFF_WT_O_A + layer * SZ_WT_O : OFF_WT_O_B + (layer - 2) * SZ_WT_O));
  f32x4 acc[2][2][4][2];
  gemm256<false>(A, 1024, Bt, 1024, 1024, brow, bcol, (LAS unsigned char*)smem, acc);
  const EpiIdx e = epi_idx();
  bf16_t* zb = (bf16_t*)(ws + OFF_XB);
  const float* stp = (const float*)(ws + OFF_STATS) + (size_t)(layer > 0 ? layer - 1 : 0) * T_TOK * 2;
  const float* g = ln_gain + (layer > 0 ? layer - 1 : 0) * 1024;
  const float* bt = ln_bias + (layer > 0 ? layer - 1 : 0) * 1024;
  float* red = (float*)smem;
  float smr[2][4], sqr[2][4];
#pragma unroll
  for (int ai = 0; ai < 2; ++ai)
#pragma unroll
    for (int m = 0; m < 4; ++m) { smr[ai][m] = 0.f; sqr[ai][m] = 0.f; }
#pragma unroll
  for (int bj = 0; bj < 2; ++bj) {
    f32x4 g4[2], b4[2];
    if (layer > 0) {
#pragma unroll
      for (int n = 0; n < 2; ++n) {
        const int col0 = bcol + bj * 128 + e.wc * 32 + n * 16 + e.fq * 4;
        g4[n] = *(const f32x4*)(g + col0);
        b4[n] = *(const f32x4*)(bt + col0);
      }
    }
#pragma unroll
    for (int ai = 0; ai < 2; ++ai)
#pragma unroll
      for (int m = 0; m < 4; ++m) {
        const int rl = ai * 128 + e.wr * 64 + m * 16 + e.fr;
        const int row = brow + rl;
        float mean = 0.f, rstd = 1.f;
        if (layer > 0) {
          const float2 st = *(const float2*)(stp + (size_t)row * 2);
          mean = st.x; rstd = st.y;
        }
        float sm = 0.f, sq = 0.f;
        u32x2 pk[2];
#pragma unroll
        for (int n = 0; n < 2; ++n) {
          const int col0 = bcol + bj * 128 + e.wc * 32 + n * 16 + e.fq * 4;
          const size_t idx = (size_t)row * 1024 + col0;
          f32x4 r;
          if (layer == 0) {
            r = *(const f32x4*)(x + idx);
          } else {
            const f32x4 zp = *(const f32x4*)(out + idx);
#pragma unroll
            for (int q = 0; q < 4; ++q) r[q] = (zp[q] - mean) * rstd * g4[n][q] + b4[n][q];
          }
          const f32x4 v = acc[ai][bj][m][n];
          f32x4 z;
#pragma unroll
          for (int q = 0; q < 4; ++q) { z[q] = DN_ALPHA * r[q] + v[q]; sm += z[q]; sq += z[q] * z[q]; }
          *(f32x4*)(out + idx) = z;
          pk[n] = pack4(z[0], z[1], z[2], z[3]);
        }
        const u32x4 w8 = gather8(pk[0], pk[1]);
        if (layer < 3) *(u32x4*)(zb + (size_t)row * 1024 + bcol + bj * 128 + e.wc * 32 + e.fq * 8) = w8;
        smr[ai][m] += sm;
        sqr[ai][m] += sq;
      }
  }
#pragma unroll
  for (int ai = 0; ai < 2; ++ai)
#pragma unroll
    for (int m = 0; m < 4; ++m) {
      const int rl = ai * 128 + e.wr * 64 + m * 16 + e.fr;
      float sm = smr[ai][m], sq = sqr[ai][m];
      sm += __shfl_xor(sm, 16); sq += __shfl_xor(sq, 16);
      sm += __shfl_xor(sm, 32); sq += __shfl_xor(sq, 32);
      if (e.fq == 0) { red[(e.wc * 256 + rl) * 2] = sm; red[(e.wc * 256 + rl) * 2 + 1] = sq; }
    }
  __syncthreads();
  {
    const int tid = otid();
    if (tid < 256) {
      float sm = 0.f, sq = 0.f;
#pragma unroll
      for (int c = 0; c < 4; ++c) { sm += red[(c * 256 + tid) * 2]; sq += red[(c * 256 + tid) * 2 + 1]; }
      float* ps = (float*)(ws + OFF_PSUM) + (size_t)(brow + tid) * 8 + nt * 2;
      ps[0] = sm;
      ps[1] = sq;
    }
  }
  __syncthreads();
}

template <bool KVT>
PHASE_FN void p5_tile(char* ws, int brow, int bcol, const bf16_t* Bt, int cbase, char* smem) {
  const bf16_t* A = (const bf16_t*)(ws + OFF_XB);
  f32x4 acc[2][2][4][2];
  gemm256<KVT>(A, 1024, Bt, 1024, 1024, brow, bcol, (LAS unsigned char*)smem, acc);
  const EpiIdx e = epi_idx();
  if (!KVT) {
    bf16_t* q = (bf16_t*)(ws + OFF_Q);
    bf16_t* sg = (bf16_t*)(ws + OFF_SGATE);
#pragma unroll
    for (int bj = 0; bj < 2; ++bj) {
      f32x4 c4[2], b4[2];
#pragma unroll
      for (int n = 0; n < 2; ++n) {
        const int col0 = bcol + bj * 128 + e.wc * 32 + n * 16 + e.fq * 4;
        c4[n] = *(const f32x4*)((const float*)(ws + OFF_CSBW) + cbase + col0);
        b4[n] = *(const f32x4*)((const float*)(ws + OFF_CSBW) + 6144 + cbase + col0);
      }
#pragma unroll
      for (int ai = 0; ai < 2; ++ai)
#pragma unroll
        for (int m = 0; m < 4; ++m) {
          const int rl = ai * 128 + e.wr * 64 + m * 16 + e.fr;
          const int row = brow + rl;
          u32x2 pk[2];
#pragma unroll
          for (int n = 0; n < 2; ++n) {
            f32x4 v = acc[ai][bj][m][n];
            {
              const float* rs = (const float*)(smem + GEMM_LDS);
              const float mean = rs[rl], rstd = rs[256 + rl];
#pragma unroll
              for (int qq = 0; qq < 4; ++qq) v[qq] = rstd * (v[qq] - mean * c4[n][qq]) + b4[n][qq];
            }
            if (bcol < 1024) pk[n] = pack4(v[0] * QSCALE_B, v[1] * QSCALE_B, v[2] * QSCALE_B, v[3] * QSCALE_B);
            else pk[n] = pack4(silu(v[0]), silu(v[1]), silu(v[2]), silu(v[3]));
          }
          const u32x4 w8 = gather8(pk[0], pk[1]);
          const int c8 = bcol + bj * 128 + e.wc * 32 + e.fq * 8;
          if (bcol < 1024) *(u32x4*)(q + (size_t)row * 1024 + c8) = w8;
          else *(u32x4*)(sg + (size_t)row * 1024 + (c8 - 1024)) = w8;
        }
    }
  } else {
    bf16_t* kb = (bf16_t*)(ws + OFF_KN);
    bf16_t* vt = (bf16_t*)(ws + OFF_VT);
    const int b = brow >> 13;
#pragma unroll
    for (int ai = 0; ai < 2; ++ai)
#pragma unroll
      for (int m = 0; m < 4; ++m)
#pragma unroll
        for (int n = 0; n < 2; ++n) {
          const float* rs = (const float*)(smem + GEMM_LDS);
          const float* csb = (const float*)(ws + OFF_CSBW) + cbase + 2048;
          {
            const int rl = ai * 128 + e.wr * 64 + m * 16 + e.fr;
            const int row = brow + rl;
            const int c0 = e.wc * 32 + n * 16 + e.fq * 4;
            const float mean = rs[rl], rstd = rs[256 + rl];
            const f32x4 c4 = *(const f32x4*)(csb + c0);
            const f32x4 b4 = *(const f32x4*)(csb + 6144 + c0);
            f32x4 v = acc[ai][0][m][n];
#pragma unroll
            for (int qq = 0; qq < 4; ++qq) v[qq] = rstd * (v[qq] - mean * c4[qq]) + b4[qq];
            *(u32x2*)(kb + (size_t)row * 128 + c0) = pack4(v[0], v[1], v[2], v[3]);
          }
          {
            const int rl = ai * 128 + e.wr * 64 + m * 16 + e.fq * 4;
            const int s = (brow + rl) & (SEQ - 1);
            const int d = e.wc * 32 + n * 16 + e.fr;
            const f32x4 mean4 = *(const f32x4*)(rs + rl), rstd4 = *(const f32x4*)(rs + 256 + rl);
            const float cc = csb[128 + d], bbv = csb[6144 + 128 + d];
            f32x4 v = acc[ai][1][m][n];
#pragma unroll
            for (int qq = 0; qq < 4; ++qq) v[qq] = rstd4[qq] * (v[qq] - mean4[qq] * cc) + bbv;
            *(u32x2*)(vt + ((size_t)((b * 2 + (d >> 6)) * 64 + (d & 63))) * SEQ + s) = pack4(v[0], v[1], v[2], v[3]);
          }
        }
  }
}

PHASE_FN void ln_phase(char* ws, float* out, const float* ln_gain, const float* ln_bias, int layer, int vb, int nb) {
  const int tid_ = otid();
  const int lane = tid_ & 63, wave = tid_ >> 6;
  const float* g = ln_gain + layer * 1024;
  const float* bta = ln_bias + layer * 1024;
  f32x4 gg[4], bb[4];
#pragma unroll
  for (int i = 0; i < 4; ++i) {
    gg[i] = *(const f32x4*)(g + i * 256 + lane * 4);
    bb[i] = *(const f32x4*)(bta + i * 256 + lane * 4);
  }
  for (int row = vb * NWAVE + wave; row < T_TOK; row += nb * NWAVE) {
    float* zr = out + (size_t)row * 1024;
    f32x4 v[4];
    float s = 0.f;
#pragma unroll
    for (int i = 0; i < 4; ++i) {
      v[i] = *(const f32x4*)(zr + i * 256 + lane * 4);
      s += v[i][0] + v[i][1] + v[i][2] + v[i][3];
    }
    const float mean = wave_sum(s) * (1.f / 1024.f);
    float q = 0.f;
#pragma unroll
    for (int i = 0; i < 4; ++i)
#pragma unroll
      for (int e = 0; e < 4; ++e) {
        const float d = v[i][e] - mean;
        q += d * d;
      }
    const float rstd = rsqrtf(wave_sum(q) * (1.f / 1024.f) + EPS);
#pragma unroll
    for (int i = 0; i < 4; ++i) {
      f32x4 y;
#pragma unroll
      for (int e = 0; e < 4; ++e) y[e] = (v[i][e] - mean) * rstd * gg[i][e] + bb[i][e];
      *(f32x4*)(zr + i * 256 + lane * 4) = y;
    }
  }
}

template <int CH>
DEV unsigned piece_off(int p, int lane, int src_row_bytes) {
  const int g = 64 * p + lane;
  const int row = g / CH;
  int c = g - row * CH;
  if (c == CH - 1) c = CH - 2;
  return (unsigned)(row * src_row_bytes + c * 16);
}
DEV void glds16(const char* src, LAS unsigned char* dst) {
#ifdef DEBUG_NO_DMA
  const u32x4 v = *(const u32x4*)src;
  *(LAS u32x4*)(dst + (threadIdx.x & 63) * 16) = v;
#else
  __builtin_amdgcn_global_load_lds((const unsigned*)src, (LAS unsigned*)dst, 16, 0, 0);
#endif
}

template <bool MLA>
PHASE_FN void attn_item(char* ws, const float* sinks, int layer, int item, char* smem) {
  constexpr int DQK = MLA ? 192 : 64;
  constexpr int DV = MLA ? 128 : 64;
  constexpr int NROW = MLA ? 272 : 144;
  constexpr int RROW = 144;
  constexpr int VROW = 144;
  constexpr int NKS = DQK / 16;
  constexpr int NDB = DV / 32;
  constexpr int KN_BYTES = 64 * NROW;
  constexpr int K_BYTES = MLA ? KN_BYTES + 64 * RROW : KN_BYTES;
  constexpr int V_BYTES = DV * VROW;
  constexpr float THR = 6.f;
  constexpr int NBUF = 3;

  item = __builtin_amdgcn_readfirstlane(item);
  const int tid = otid(), lane = tid & 63;
  const int wu = __builtin_amdgcn_readfirstlane(tid >> 6);
  const int w = wu;
  const int h = lane >> 5, l31 = lane & 31;
  LAS unsigned char* lds = (LAS unsigned char*)smem;
  float* bias_s = (float*)(smem + NBUF * K_BYTES + NBUF * V_BYTES);

  int b, hd, qrow0, tile0, nt_blk, nt_mine;
  int hq = 0, cq = 0;
  if (MLA) {
    b = item >> 8;
    hd = (item >> 5) & 7;
    const int i = item & 31;
    qrow0 = b * SEQ + 256 * i + 32 * w;
    tile0 = 0;
    nt_blk = 4 * i + 4;
    nt_mine = 4 * i + 1 + (w >> 1);
  } else {
    const int sub = item & 1;
    cq = (item >> 1) & 127;
    hd = (item >> 8) & 1;
    b = item >> 9;
    hq = hd * 8 + sub * 4 + (w >> 1);
    qrow0 = b * SEQ + 64 * cq + 32 * (w & 1);
    tile0 = cq >= 2 ? cq - 2 : 0;
    nt_blk = cq - tile0 + 1;
    nt_mine = nt_blk;
  }

  bf16x8 qf[NKS];
  {
    const bf16_t* qp = (const bf16_t*)(ws + OFF_Q);
    const bf16_t* src = MLA ? qp + (size_t)(qrow0 + l31) * 1536 + hd * 192 + h * 8
                            : qp + (size_t)(qrow0 + l31) * 1024 + hq * 64 + h * 8;
#pragma unroll
    for (int ks = 0; ks < NKS; ++ks) qf[ks] = *(const bf16x8*)(src + ks * 16);
  }

  const char* kbase = MLA ? (const char*)(ws + OFF_KN) + ((size_t)b * SEQ + (size_t)tile0 * 64) * 2048 + hd * 256
                          : (const char*)(ws + OFF_KN) + ((size_t)b * SEQ + (size_t)tile0 * 64) * 256 + hd * 128;
  const char* rbase = (const char*)(ws + OFF_KROPE) + ((size_t)b * SEQ + (size_t)tile0 * 64) * 128;
  const char* vbase = MLA ? (const char*)(ws + OFF_VT) + ((size_t)(b * 8 + hd) * 128) * (SEQ * 2) + (size_t)tile0 * 128
                          : (const char*)(ws + OFF_VT) + ((size_t)(b * 2 + hd) * 64) * (SEQ * 2) + (size_t)tile0 * 128;
  unsigned po0, po1, po2 = 0, po3 = 0, po4 = 0, po5 = 0;
  if (MLA) {
    po0 = piece_off<17>(wu, lane, 2048);
    po1 = piece_off<17>(wu + 8, lane, 2048);
    po2 = piece_off<9>(wu, lane, 128);
    po3 = piece_off<9>(wu, lane, SEQ * 2);
    po4 = piece_off<9>(wu + 8, lane, SEQ * 2);
    po5 = wu == 0 ? piece_off<17>(16, lane, 2048) : wu == 1 ? piece_off<9>(8, lane, 128) : piece_off<9>(wu == 2 ? 16 : 17, lane, SEQ * 2);
  } else {
    po0 = piece_off<9>(wu, lane, 256);
    po1 = piece_off<9>(wu, lane, SEQ * 2);
    po5 = wu == 0 ? piece_off<9>(8, lane, 256) : piece_off<9>(8, lane, SEQ * 2);
  }
  auto issue_k = [&](int tj, int slot) {
    LAS unsigned char* img = lds + slot * K_BYTES;
    if (MLA) {
      const char* kb = kbase + (size_t)tj * (64 * 2048);
      const char* rb = rbase + (size_t)tj * (64 * 128);
      glds16(kb + po0, img + wu * 1024);
      glds16(kb + po1, img + (wu + 8) * 1024);
      glds16(rb + po2, img + KN_BYTES + wu * 1024);
      if (wu == 0) glds16(kb + po5, img + 16 * 1024);
      else if (wu == 1) glds16(rb + po5, img + KN_BYTES + 8 * 1024);
    } else {
      const char* kb = kbase + (size_t)tj * (64 * 256);
      glds16(kb + po0, img + wu * 1024);
      if (wu == 0) glds16(kb + po5, img + 8 * 1024);
    }
  };
  auto issue_v = [&](int tj, int slot) {
    LAS unsigned char* img = lds + NBUF * K_BYTES + slot * V_BYTES;
    const char* vb = vbase + (size_t)tj * 128;
    if (MLA) {
      glds16(vb + po3, img + wu * 1024);
      glds16(vb + po4, img + (wu + 8) * 1024);
      if (wu == 2 || wu == 3) glds16(vb + po5, img + (14 + wu) * 1024);
    } else {
      glds16(vb + po1, img + wu * 1024);
      if (wu == 1) glds16(vb + po5, img + 8 * 1024);
    }
  };
  const int sig = (l31 & 0x13) | ((l31 & 4) << 1) | ((l31 & 8) >> 1);
  const int kofs = sig * NROW + h * 16;
  const int rofs = KN_BYTES + sig * RROW + h * 16;
  const int vofs = NBUF * K_BYTES + l31 * VROW + h * 16;
  auto kfrag = [&](const char* Ks, int ks, int kb) -> bf16x8 {
    if (MLA && ks >= 8) return *(const bf16x8*)(Ks + rofs + kb * 32 * RROW + (ks - 8) * 32);
    return *(const bf16x8*)(Ks + kofs + kb * 32 * NROW + ks * 32);
  };
  auto qk_tile = [&](int slot, float init, f32x16& s0, f32x16& s1) {
    const char* Ks = smem + slot * K_BYTES;
#pragma unroll
    for (int r = 0; r < 16; ++r) { s0[r] = init; s1[r] = init; }
    bf16x8 ka[3][2];
    ka[0][0] = kfrag(Ks, 0, 0);
    ka[0][1] = kfrag(Ks, 0, 1);
    ka[1][0] = kfrag(Ks, 1, 0);
    ka[1][1] = kfrag(Ks, 1, 1);
#pragma unroll
    for (int ks = 0; ks < NKS; ++ks) {
      if (ks + 2 < NKS) {
        ka[(ks + 2) % 3][0] = kfrag(Ks, ks + 2, 0);
        ka[(ks + 2) % 3][1] = kfrag(Ks, ks + 2, 1);
      }
      s0 = __builtin_amdgcn_mfma_f32_32x32x16_bf16(ka[ks % 3][0], qf[ks], s0, 0, 0, 0);
      s1 = __builtin_amdgcn_mfma_f32_32x32x16_bf16(ka[ks % 3][1], qf[ks], s1, 0, 0, 0);
      __builtin_amdgcn_sched_barrier(0);
    }
  };

  float m_run, l_run;
  __syncthreads();
  issue_k(0, 0);
  issue_v(0, 0);
  if (nt_blk > 1) { issue_k(1, 1); issue_v(1, 1); }
  if (MLA) {
    m_run = 0.f;
    l_run = 0.f;
  } else {
    const float* bt = (const float*)(ws + OFF_BIAS);
    const int sub = item & 1;
    for (int i = tid; i < 1024; i += NTHR) bias_s[i] = bt[(hd * 8 + sub * 4 + (i >> 8)) * 256 + (i & 255)];
    m_run = sinks[(layer - 2) * 16 + hq] * LOG2E;
    l_run = (h == 0) ? 1.f : 0.f;
  }
  asm volatile("s_waitcnt vmcnt(0)" ::: "memory");
  __syncthreads();
  __syncthreads();

  f32x16 o[NDB];
#pragma unroll
  for (int db = 0; db < NDB; ++db)
#pragma unroll
    for (int r = 0; r < 16; ++r) o[db][r] = 0.f;

  auto bias_max = [&](int tj, f32x16& s0, f32x16& s1) -> float {
    if (!MLA) {
      const int kc = tile0 + tj;
      const int base = (kc - cq) * 64 - 32 * (w & 1) - l31 + 191 + 8 * h;
      const float* bs = bias_s + (w >> 1) * 256 + base;
#pragma unroll
      for (int r = 0; r < 16; ++r) {
        const int ko = 16 * (r >> 3) + 4 * ((r >> 2) & 1) + (r & 3);
        s0[r] += bs[ko];
        s1[r] += bs[32 + ko];
      }
    }
    float mx = s0[0];
#pragma unroll
    for (int r = 1; r < 16; ++r) mx = fmaxf(mx, s0[r]);
#pragma unroll
    for (int r = 0; r < 16; ++r) mx = fmaxf(mx, s1[r]);
    return swapmax(mx);
  };
  auto raise = [&](float mx, f32x16& s0, f32x16& s1) {
    if (!__all(mx <= THR)) {
      const float dlt = fmaxf(mx, 0.f);
      const float alpha = __builtin_amdgcn_exp2f(-dlt);
      m_run += dlt;
      l_run *= alpha;
#pragma unroll
      for (int db = 0; db < NDB; ++db)
#pragma unroll
        for (int r = 0; r < 16; ++r) o[db][r] *= alpha;
#pragma unroll
      for (int r = 0; r < 16; ++r) { s0[r] -= dlt; s1[r] -= dlt; }
    }
  };

  int slot = 0;
  for (int tj = 0; tj < nt_blk; ++tj) {
    if (tj + 2 < nt_blk) { const int s2 = (slot >= 1) ? slot - 1 : 2; issue_k(tj + 2, s2); issue_v(tj + 2, s2); }
    if (tj < nt_mine) {
      f32x16 c0, c1;
      qk_tile(slot, (MLA && tj == 0) ? 0.f : -m_run, c0, c1);
      const float mx = bias_max(tj, c0, c1);
      if (MLA && tj == 0) {
        m_run = mx;
#pragma unroll
        for (int r = 0; r < 16; ++r) { c0[r] -= mx; c1[r] -= mx; }
      } else {
        raise(mx, c0, c1);
      }
      float ps = 0.f;
#pragma unroll
      for (int r = 0; r < 16; ++r) {
        c0[r] = __builtin_amdgcn_exp2f(c0[r]);
        c1[r] = __builtin_amdgcn_exp2f(c1[r]);
        ps += c0[r] + c1[r];
      }
      l_run += ps;
      bf16x8 pb[4];
      {
        u32x4 t0 = {cvtpk(c0[0], c0[1]), cvtpk(c0[2], c0[3]), cvtpk(c0[4], c0[5]), cvtpk(c0[6], c0[7])};
        u32x4 t1 = {cvtpk(c0[8], c0[9]), cvtpk(c0[10], c0[11]), cvtpk(c0[12], c0[13]), cvtpk(c0[14], c0[15])};
        u32x4 t2 = {cvtpk(c1[0], c1[1]), cvtpk(c1[2], c1[3]), cvtpk(c1[4], c1[5]), cvtpk(c1[6], c1[7])};
        u32x4 t3 = {cvtpk(c1[8], c1[9]), cvtpk(c1[10], c1[11]), cvtpk(c1[12], c1[13]), cvtpk(c1[14], c1[15])};
        pb[0] = *(bf16x8*)&t0; pb[1] = *(bf16x8*)&t1; pb[2] = *(bf16x8*)&t2; pb[3] = *(bf16x8*)&t3;
      }
      const char* Vs = smem + slot * V_BYTES;
      bf16x8 va[2][4];
#pragma unroll
      for (int t = 0; t < 4; ++t) va[0][t] = *(const bf16x8*)(Vs + vofs + t * 32);
#pragma unroll
      for (int db = 0; db < NDB; ++db) {
        if (db + 1 < NDB) {
#pragma unroll
          for (int t = 0; t < 4; ++t) va[(db + 1) & 1][t] = *(const bf16x8*)(Vs + vofs + (db + 1) * 32 * VROW + t * 32);
        }
#pragma unroll
        for (int t = 0; t < 4; ++t) o[db] = __builtin_amdgcn_mfma_f32_32x32x16_bf16(va[db & 1][t], pb[t], o[db], 0, 0, 0);
      }
    }
    asm volatile("s_waitcnt vmcnt(0)" ::: "memory");
    __syncthreads();
    slot = (slot == 2) ? 0 : slot + 1;
  }

  const float inv = 1.f / swapsum(l_run);
  const int row = qrow0 + l31;
  const int colbase = MLA ? hd * 128 : hq * 64;
  const bf16_t* sg = (const bf16_t*)(ws + OFF_SGATE) + (size_t)row * 1024 + colbase;
  bf16_t* og = (bf16_t*)(ws + OFF_OG) + (size_t)row * 1024 + colbase;
#pragma unroll
  for (int db = 0; db < NDB; ++db)
#pragma unroll
    for (int k = 0; k < 2; ++k) {
      float ev[8];
#pragma unroll
      for (int j = 0; j < 4; ++j) {
        auto sw = __builtin_amdgcn_permlane32_swap(__float_as_uint(o[db][(2 * k) * 4 + j]), __float_as_uint(o[db][(2 * k + 1) * 4 + j]), false, false);
        ev[j] = __uint_as_float(sw[0]);
        ev[4 + j] = __uint_as_float(sw[1]);
      }
      const int d = 32 * db + 16 * k + 8 * h;
      const u32x4 gv = *(const u32x4*)(sg + d);
      u32x4 ov;
#pragma unroll
      for (int i = 0; i < 4; ++i) {
        const float g0 = __uint_as_float(gv[i] << 16), g1 = __uint_as_float(gv[i] & 0xffff0000u);
        ov[i] = cvtpk(ev[2 * i] * inv * g0, ev[2 * i + 1] * inv * g1);
      }
      *(u32x4*)(og + d) = ov;
    }
}

PHASE_FN void swa_phase(char* ws, const float* sinks, int layer, int vb, int nb, char* smem) {
  constexpr int TB = 9216;
  constexpr int BUFB = 6 * TB;
  constexpr float THR = 6.f;
  const int tid = otid(), lane = tid & 63;
  const int wu = __builtin_amdgcn_readfirstlane(tid >> 6);
  const int h = lane >> 5, l31 = lane & 31;
  LAS unsigned char* lds = (LAS unsigned char*)smem;
  float* bias_s = (float*)(smem + 2 * BUFB);
  if (vb >= 256) return;
  const int hk = (vb >> 7) & 1, cq = vb & 127;
  const int tile0 = cq >= 2 ? cq - 2 : 0, ntl = cq - tile0 + 1;
  const int npieces = ntl * 18;
  __syncthreads();
  {
    const float* bt = (const float*)(ws + OFF_BIAS);
    for (int i = tid; i < 2048; i += NTHR) bias_s[i] = bt[(hk * 8 + (i >> 8)) * 256 + (i & 255)];
  }
  const int nitem = (vb + 3 * 256 < 1024) ? 4 : ((1024 - vb + 255) >> 8);
  auto issue_item = [&](int b, int buf) {
    const char* kbase = (const char*)(ws + OFF_KN) + ((size_t)b * SEQ + (size_t)tile0 * 64) * 256 + hk * 128;
    const char* vbase = (const char*)(ws + OFF_VT) + ((size_t)(b * 2 + hk) * 64) * (SEQ * 2) + (size_t)tile0 * 128;
#pragma unroll
    for (int i = 0; i < 7; ++i) {
      int P = wu + 8 * i;
      if (P >= npieces) P = wu;
      const int tile = P / 18, r = P - tile * 18;
      const bool isv = r >= 9;
      const int p = isv ? r - 9 : r;
      const char* src = isv ? vbase + (size_t)tile * 128 + piece_off<9>(p, lane, SEQ * 2)
                            : kbase + (size_t)tile * (64 * 256) + piece_off<9>(p, lane, 256);
      glds16(src, lds + buf * BUFB + (isv ? 3 * TB : 0) + tile * TB + p * 1024);
    }
  };
  const int qoff = (64 * cq + 32 * (wu & 1) + l31) * 1024 + (hk * 8 + (wu >> 1)) * 64 + h * 8;
  const bf16_t* qp = (const bf16_t*)(ws + OFF_Q);
  bf16x8 qn[2][4];
  issue_item(0, 0);
#pragma unroll
  for (int s2 = 0; s2 < 2; ++s2)
#pragma unroll
    for (int ks = 0; ks < 4; ++ks) qn[s2][ks] = *(const bf16x8*)(qp + qoff + s2 * 256 + ks * 16);
  asm volatile("s_waitcnt vmcnt(0)" ::: "memory");
  __syncthreads();
  const int sig = (l31 & 0x13) | ((l31 & 4) << 1) | ((l31 & 8) >> 1);
  const int kofs = sig * 144 + h * 16;
  const int vofs = 3 * TB + l31 * 144 + h * 16;
  for (int b = 0; b < nitem; ++b) {
    const int buf = b & 1;
    bf16x8 qc[2][4];
#pragma unroll
    for (int s2 = 0; s2 < 2; ++s2)
#pragma unroll
      for (int ks = 0; ks < 4; ++ks) qc[s2][ks] = qn[s2][ks];
    if (b + 1 < nitem) {
      issue_item(b + 1, buf ^ 1);
#pragma unroll
      for (int s2 = 0; s2 < 2; ++s2)
#pragma unroll
        for (int ks = 0; ks < 4; ++ks) qn[s2][ks] = *(const bf16x8*)(qp + (size_t)(b + 1) * SEQ * 1024 + qoff + s2 * 256 + ks * 16);
    }
    __syncthreads();
    const char* Kb = smem + buf * BUFB;
#pragma unroll 1
    for (int s2 = 0; s2 < 2; ++s2) {
      const int g = s2 * 4 + (wu >> 1);
      const int hq = hk * 8 + g;
      const int row = b * SEQ + 64 * cq + 32 * (wu & 1) + l31;
      const bf16_t* sg = (const bf16_t*)(ws + OFF_SGATE) + (size_t)row * 1024 + hq * 64;
      u32x4 gv[2][2];
#pragma unroll
      for (int db = 0; db < 2; ++db)
#pragma unroll
        for (int k = 0; k < 2; ++k) gv[db][k] = *(const u32x4*)(sg + 32 * db + 16 * k + 8 * h);
      float m_run = sinks[(layer - 2) * 16 + hq] * LOG2E;
      float l_run = (h == 0) ? 1.f : 0.f;
      f32x16 o[2];
#pragma unroll
      for (int db = 0; db < 2; ++db)
#pragma unroll
        for (int r = 0; r < 16; ++r) o[db][r] = 0.f;
      for (int tj = 0; tj < ntl; ++tj) {
        const char* Ks = Kb + tj * TB;
        f32x16 c0, c1;
        {
          const float ninit = -m_run;
#pragma unroll
          for (int r = 0; r < 16; ++r) { c0[r] = ninit; c1[r] = ninit; }
        }
#pragma unroll
        for (int ks = 0; ks < 4; ++ks) {
          const bf16x8 a0 = *(const bf16x8*)(Ks + kofs + ks * 32);
          const bf16x8 a1 = *(const bf16x8*)(Ks + kofs + 32 * 144 + ks * 32);
          const bf16x8 qb = s2 == 0 ? qc[0][ks] : qc[1][ks];
          c0 = __builtin_amdgcn_mfma_f32_32x32x16_bf16(a0, qb, c0, 0, 0, 0);
          c1 = __builtin_amdgcn_mfma_f32_32x32x16_bf16(a1, qb, c1, 0, 0, 0);
        }
        {
          const int base = (tile0 + tj - cq) * 64 - 32 * (wu & 1) - l31 + 191 + 8 * h;
          const float* bs = bias_s + g * 256 + base;
#pragma unroll
          for (int r = 0; r < 16; ++r) {
            const int ko = 16 * (r >> 3) + 4 * ((r >> 2) & 1) + (r & 3);
            c0[r] += bs[ko];
            c1[r] += bs[32 + ko];
          }
        }
        float mx = c0[0];
#pragma unroll
        for (int r = 1; r < 16; ++r) mx = fmaxf(mx, c0[r]);
#pragma unroll
        for (int r = 0; r < 16; ++r) mx = fmaxf(mx, c1[r]);
        mx = swapmax(mx);
        if (!__all(mx <= THR)) {
          const float dlt = fmaxf(mx, 0.f);
          const float alpha = __builtin_amdgcn_exp2f(-dlt);
          m_run += dlt;
          l_run *= alpha;
#pragma unroll
          for (int db = 0; db < 2; ++db)
#pragma unroll
            for (int r = 0; r < 16; ++r) o[db][r] *= alpha;
#pragma unroll
          for (int r = 0; r < 16; ++r) { c0[r] -= dlt; c1[r] -= dlt; }
        }
        float ps = 0.f;
#pragma unroll
        for (int r = 0; r < 16; ++r) {
          c0[r] = __builtin_amdgcn_exp2f(c0[r]);
          c1[r] = __builtin_amdgcn_exp2f(c1[r]);
          ps += c0[r] + c1[r];
        }
        l_run += ps;
        bf16x8 pb[4];
        {
          u32x4 t0 = {cvtpk(c0[0], c0[1]), cvtpk(c0[2], c0[3]), cvtpk(c0[4], c0[5]), cvtpk(c0[6], c0[7])};
          u32x4 t1 = {cvtpk(c0[8], c0[9]), cvtpk(c0[10], c0[11]), cvtpk(c0[12], c0[13]), cvtpk(c0[14], c0[15])};
          u32x4 t2 = {cvtpk(c1[0], c1[1]), cvtpk(c1[2], c1[3]), cvtpk(c1[4], c1[5]), cvtpk(c1[6], c1[7])};
          u32x4 t3 = {cvtpk(c1[8], c1[9]), cvtpk(c1[10], c1[11]), cvtpk(c1[12], c1[13]), cvtpk(c1[14], c1[15])};
          pb[0] = *(bf16x8*)&t0; pb[1] = *(bf16x8*)&t1; pb[2] = *(bf16x8*)&t2; pb[3] = *(bf16x8*)&t3;
        }
        const char* Vs = Kb + tj * TB;
#pragma unroll
        for (int db = 0; db < 2; ++db)
#pragma unroll
          for (int t = 0; t < 4; ++t) {
            const bf16x8 va = *(const bf16x8*)(Vs + vofs + db * 32 * 144 + t * 32);
            o[db] = __builtin_amdgcn_mfma_f32_32x32x16_bf16(va, pb[t], o[db], 0, 0, 0);
          }
      }
      const float inv = 1.f / swapsum(l_run);
      bf16_t* og = (bf16_t*)(ws + OFF_OG) + (size_t)row * 1024 + hq * 64;
#pragma unroll
      for (int db = 0; db < 2; ++db)
#pragma unroll
        for (int k = 0; k < 2; ++k) {
          float ev[8];
#pragma unroll
          for (int j = 0; j < 4; ++j) {
            auto sw = __builtin_amdgcn_permlane32_swap(__float_as_uint(o[db][(2 * k) * 4 + j]), __float_as_uint(o[db][(2 * k + 1) * 4 + j]), false, false);
            ev[j] = __uint_as_float(sw[0]);
            ev[4 + j] = __uint_as_float(sw[1]);
          }
          const int d = 32 * db + 16 * k + 8 * h;
          const u32x4 g4 = gv[db][k];
          u32x4 ov;
#pragma unroll
          for (int i = 0; i < 4; ++i) {
            const float g0 = __uint_as_float(g4[i] << 16), g1 = __uint_as_float(g4[i] & 0xffff0000u);
            ov[i] = cvtpk(ev[2 * i] * inv * g0, ev[2 * i + 1] * inv * g1);
          }
          *(u32x4*)(og + d) = ov;
        }
    }
    asm volatile("s_waitcnt vmcnt(0)" ::: "memory");
    __syncthreads();
  }
}

#define XB_TMO      128
#define XB_XCNT(j)  (256  + 64 * (j))
#define XB_XSUB(j)  (1280 + 64 * (j))
#define XB_XGEN(j)  (2304 + 64 * (j))
#define XB_TOP      3328
#define XB_TOPGEN   3392
#define XCD_BAR_WORDS 3456
#define XB_SPIN_CAP (1u << 22)
DEV unsigned xb_ld(unsigned* p) { return __hip_atomic_load(p, __ATOMIC_RELAXED, __HIP_MEMORY_SCOPE_AGENT); }
DEV unsigned xb_add(unsigned* p, unsigned v) { return __hip_atomic_fetch_add(p, v, __ATOMIC_RELAXED, __HIP_MEMORY_SCOPE_AGENT); }
DEV unsigned xb_xcc_id() { return (unsigned)__builtin_amdgcn_s_getreg((3 << 11) | 20) & 0xFu; }
#define XB_SPIN(cond, bar) do { unsigned _sp = 0; while (cond) { __builtin_amdgcn_s_sleep(1); \
    if ((++_sp & 255u) == 0u) { if (xb_ld(&(bar)[XB_TMO])) break; if (_sp > XB_SPIN_CAP) { atomicAdd(&(bar)[XB_TMO], 1u); break; } } } } while (0)
struct XcdBarrier { unsigned* bar; unsigned x; volatile LAS unsigned* st; };
DEV XcdBarrier xcd_barrier_post(unsigned* bar, volatile LAS unsigned* st) {
  XcdBarrier b; b.bar = bar; b.x = xb_xcc_id(); b.st = st;
  if (threadIdx.x == 0) (void)xb_add(&bar[XB_XCNT(b.x)], 1u);
  return b;
}
DEV void xcd_barrier_complete(unsigned* bar, unsigned x, unsigned& nloc, unsigned& nx) {
  const unsigned G = gridDim.x * gridDim.y * gridDim.z;
  unsigned sum, cnt, mine, sp = 0u;
  for (;;) {
    sum = 0u; cnt = 0u; mine = 0u;
#pragma unroll
    for (unsigned j = 0; j < 16; ++j) { const unsigned c = xb_ld(&bar[XB_XCNT(j)]); sum += c; cnt += (c > 0u) ? 1u : 0u; mine = (j == x) ? c : mine; }
    if (sum == G) break;
    __builtin_amdgcn_s_sleep(1);
    if ((++sp & 255u) == 0u) { if (xb_ld(&bar[XB_TMO])) break; if (sp > XB_SPIN_CAP) { atomicAdd(&bar[XB_TMO], 1u); break; } }
  }
  nloc = mine > 0u ? mine : 1u; nx = cnt > 0u ? cnt : 1u;
}
DEV void xcd_barrier(const XcdBarrier& b) {
  asm volatile("s_waitcnt vmcnt(0)" ::: "memory");
  __syncthreads();
  if (threadIdx.x == 0) {
    unsigned* bar = b.bar;
    __builtin_amdgcn_s_waitcnt(0);
    unsigned nloc = b.st[0], nx = b.st[1];
    if (nloc == 0u) { xcd_barrier_complete(bar, b.x, nloc, nx); b.st[0] = nloc; b.st[1] = nx; }
    const unsigned old = xb_add(&bar[XB_XSUB(b.x)], 1u);
    const unsigned gen = old / nloc;
    if (old + 1u == (gen + 1u) * nloc) {
      __builtin_amdgcn_fence(__ATOMIC_RELEASE, "agent");
      asm volatile("s_waitcnt vmcnt(0)" ::: "memory");
      const unsigned og = xb_add(&bar[XB_TOP], 1u);
      const unsigned tg = og / nx;
      if (og + 1u == (tg + 1u) * nx) xb_add(&bar[XB_TOPGEN], 1u);
      else XB_SPIN(xb_ld(&bar[XB_TOPGEN]) == tg, bar);
      __builtin_amdgcn_fence(__ATOMIC_ACQUIRE, "agent");
      xb_add(&bar[XB_XGEN(b.x)], 1u);
      asm volatile("s_waitcnt vmcnt(0)" ::: "memory");
    } else {
      XB_SPIN(xb_ld(&bar[XB_XGEN(b.x)]) == gen, bar);
      __builtin_amdgcn_fence(__ATOMIC_ACQUIRE, "agent");
      asm volatile("s_waitcnt vmcnt(0)" ::: "memory");
    }
  }
  __syncthreads();
}

constexpr int N_PHASES = 1 + 2 * 4 + 2 * 3 + 1;

__global__ void __launch_bounds__(512, 2) yoco_megakernel(Params p) {
  extern __shared__ __attribute__((aligned(16))) char smem[];
  cg::grid_group grid = cg::this_grid();
  const int nb = gridDim.x;
  const int vb = ((nb & 7) == 0) ? (int)((blockIdx.x & 7) * (nb >> 3) + (blockIdx.x >> 3)) : (int)blockIdx.x;
  __shared__ int s_item;
  __shared__ uint4 xb_words;
  if (threadIdx.x == 0) xb_words = make_uint4(0u, 0u, 0u, 0u);
  __syncthreads();
  const XcdBarrier xb = xcd_barrier_post((unsigned*)(p.ws + OFF_BAR), (volatile LAS unsigned*)&xb_words);

  int ph0 = p.phase_lo;
  bool need_sync = false;
  if (ph0 == 0) {
    phase0(p, vb, nb, smem);
#if PROBE == 5
    __syncthreads();
    phase0(p, vb, nb, smem);
#endif
    ph0 = 1;
    if (p.phase_hi > 1) grid.sync();
  }
  for (int ph = ph0; ph < p.phase_hi; ++ph) {
    if (need_sync) xcd_barrier(xb);
    need_sync = true;
    int layer, sub;
    if (ph <= 8) { layer = (ph - 1) >> 2; sub = (ph - 1) & 3; }
    else if (ph <= 14) { layer = 2 + (ph - 9) / 3; sub = (ph - 9) % 3; if (sub > 0) sub += 1; }
    else { layer = 3; sub = 4; }
    char* ws = p.ws;
    float* outp = p.out;
    asm volatile("" : "+s"(ws), "+s"(outp), "+s"(layer));
    if (sub == 4) {
      ln_phase(ws, outp, p.in[12], p.in[13], layer, vb, nb);
    } else if (layer < 2) {
      if (sub == 0) {
        if (layer == 0) fold_reduce(ws, vb, nb);
        for (int t = vb; t < 128 * 7; t += nb) {
          if (layer == 1) ln_stats(ws, 0, (t / 7) * 256, smem);
          p1_tile(ws, layer, t, smem);
        }
      } else if (sub == 1) {
        const int total = 128 * 14;
        const int per = (total + nb - 1) / nb;
        int lo = vb * per, hi = lo + per;
        if (hi > total) hi = total;
        int cur_mt = -1;
        for (int t = lo; t < hi; ++t) {
          const int mt = t / 14, nt = t % 14;
          if (mt != cur_mt) { p2_rowscale(ws, mt * 256, smem); cur_mt = mt; }
          p2_tile(ws, layer, mt, nt, smem);
        }
      } else if (sub == 2) {
        int* cnt = (int*)(ws + OFF_CNT) + layer * 8;
        const int xq0 = (int)(xb_xcc_id() & 7u);
        for (int qi = 0; qi < 8; ++qi) {
          const int xq = (xq0 + qi) & 7;
          for (;;) {
            __syncthreads();
            if (threadIdx.x == 0) s_item = atomicAdd(cnt + xq, 1);
            __syncthreads();
            const int e = s_item;
            if (e >= 128) break;
            const int pair = xq * 4 + (e >> 5);
            const int item = (pair << 5) | (31 - (e & 31));
            attn_item<true>(ws, p.in[9], layer, item, smem);
          }
        }
      } else {
        for (int t = vb; t < 128 * 4; t += nb) pout_tile(ws, outp, p.in[0], p.in[12], p.in[13], layer, t, smem);
      }
    } else {
      if (sub == 0) {
        const bf16_t* Bt = (const bf16_t*)(ws + (layer == 2 ? OFF_WT_IN_B0 : OFF_WT_IN_B1));
        const int cbase = (layer == 2) ? 1792 : 4096;
        for (int t = vb; t < 128 * 8; t += nb) {
          ln_stats(ws, layer - 1, (t >> 3) * 256, smem);
          p5_tile<false>(ws, (t >> 3) * 256, (t & 7) * 256, Bt, cbase, smem);
        }
        if (layer == 2)
          for (int t = vb; t < 128; t += nb) {
            ln_stats(ws, layer - 1, t * 256, smem);
            p5_tile<true>(ws, t * 256, 2048, Bt, cbase, smem);
          }
      } else if (sub == 2) {
        if (nb == 256) swa_phase(ws, p.in[9], layer, vb, nb, smem);
        else for (int t = vb; t < 2048; t += nb) attn_item<false>(ws, p.in[9], layer, t, smem);
      } else {
        for (int t = vb; t < 128 * 4; t += nb) pout_tile(ws, outp, p.in[0], p.in[12], p.in[13], layer, t, smem);
      }
    }
  }
}

extern "C" void kernel_launch(void* const* d_in, const int* in_sizes, int n_in, void* d_out, int out_size, void* d_ws,
                              size_t ws_size, hipStream_t stream) {
  (void)in_sizes; (void)n_in; (void)out_size;
  if (ws_size < WS_NEEDED) {
    fprintf(stderr, "workspace too small: %zu < %zu\n", ws_size, (size_t)WS_NEEDED);
    return;
  }
  Params p;
  memset(&p, 0, sizeof(p));
  for (int i = 0; i < 14; ++i) p.in[i] = (const float*)d_in[i];
  p.out = (float*)d_out;
  p.ws = (char*)d_ws;

  static int grid_blocks = 0;
  if (!grid_blocks) {
    int dev = 0, cus = 0, per_cu = 0;
    hipGetDevice(&dev);
    hipDeviceGetAttribute(&cus, hipDeviceAttributeMultiprocessorCount, dev);
    hipFuncSetAttribute((const void*)yoco_megakernel, hipFuncAttributeMaxDynamicSharedMemorySize, SMEM_BYTES);
    hipOccupancyMaxActiveBlocksPerMultiprocessor(&per_cu, yoco_megakernel, NTHR, SMEM_BYTES);
    if (per_cu > 1) per_cu = 1;
    if (per_cu < 1) per_cu = 1;
    grid_blocks = cus * per_cu;
  }
#ifdef MULTI_LAUNCH
  for (int ph = 0; ph < N_PHASES; ++ph) {
    p.phase_lo = ph; p.phase_hi = ph + 1;
    hipLaunchKernelGGL(yoco_megakernel, dim3(grid_blocks), dim3(NTHR), SMEM_BYTES, stream, p);
  }
#else
  p.phase_lo = 0; p.phase_hi = N_PHASES;
  (void)hipMemsetAsync((char*)d_ws + OFF_BAR, 0, 16384, stream);
  void* args[] = {&p};
  hipError_t e = hipLaunchCooperativeKernel((void*)yoco_megakernel, dim3(grid_blocks), dim3(NTHR), args, SMEM_BYTES, stream);
  if (e != hipSuccess) fprintf(stderr, "cooperative launch failed: %s (grid %d)\n", hipGetErrorString(e), grid_blocks);
#endif
}
```
